# Optimizing an MI355X kernel written in HIP

```python
import math
import jax
import jax.numpy as jnp
from jax import lax
import numpy as np

D_MODEL = 1024
BATCH = 16
SEQ = 2048
DEPTH = 4

N_MIXERS = 4
NORM_EPS = 1e-6
ROPE_THETA = 10000.0
HEAD_DIM = 64
NEG_INF = -1e30

POOL_WINDOWS = (2, 4, 8, 16)
POOL_GROUP = D_MODEL // len(POOL_WINDOWS)

DIFF_HEADS = D_MODEL // (2 * HEAD_DIM)
DIFF_SUBLN_EPS = 1e-5
Q_BLOCK = 128

LRU_WIDTH = D_MODEL
LRU_BLOCKS = D_MODEL // HEAD_DIM
LRU_BLOCK_DIM = LRU_WIDTH // LRU_BLOCKS
LRU_CONV = 4
LRU_C = 8.0

DIL_GROUPS = ((128, 1), (512, 4), (2048, 16))
DIL_HEADS = D_MODEL // HEAD_DIM
DIL_WIDTH = DIL_HEADS * HEAD_DIM

D_FF = 2816
FFN_CONV = 3

kernel_name = "hybrid_pool_diffattn_rglru_dilated_encoder"


def _n_layers_of(mixer):
    return len(range(mixer, DEPTH, N_MIXERS))


def _rms_norm(x, gain, eps=NORM_EPS):
    xf = x.astype(jnp.float32)
    y = xf * lax.rsqrt(jnp.mean(xf * xf, axis=-1, keepdims=True) + eps)
    return (y * gain.astype(jnp.float32)).astype(x.dtype)


def _rope_tables(positions, head_dim):
    inv = ROPE_THETA ** (-jnp.arange(0, head_dim, 2, dtype=jnp.float32) / head_dim)
    ang = positions.astype(jnp.float32)[:, None] * inv[None, :]
    return jnp.cos(ang), jnp.sin(ang)


def _rope(x, cos, sin):
    shape = (cos.shape[0],) + (1,) * (x.ndim - 3) + (cos.shape[1],)
    c, s = cos.reshape(shape), sin.reshape(shape)
    xf = x.astype(jnp.float32)
    x1, x2 = jnp.split(xf, 2, axis=-1)
    return jnp.concatenate([x1 * c - x2 * s, x2 * c + x1 * s], axis=-1).astype(x.dtype)


def _pool_mixer(x, w, scale):
    b, s, d = x.shape
    xf = x.astype(jnp.float32)
    cs = jnp.concatenate([jnp.zeros((b, 1, d), jnp.float32), lax.cumsum(xf, axis=1)], axis=1)
    t = jnp.arange(s)
    parts = []
    for g, win in enumerate(POOL_WINDOWS):
        lo = jnp.clip(t - win // 2, 0, s)
        hi = jnp.clip(t + win - win // 2, 0, s)
        sl = slice(g * POOL_GROUP, (g + 1) * POOL_GROUP)
        csg = cs[:, :, sl]
        mean = (csg[:, hi] - csg[:, lo]) / (hi - lo).astype(jnp.float32)[:, None]
        parts.append(mean - xf[:, :, sl])
    pooled = jnp.stack(parts, axis=2).astype(x.dtype)
    y = jnp.einsum('bsgc,gce->bsge', pooled, w).reshape(b, s, d)
    return y * scale


def _diff_attention(x, w_qkv, lq1, lk1, lq2, lk2, subln, w_o, cos, sin, layer_idx):
    b, s, _ = x.shape
    h, dh = DIFF_HEADS, HEAD_DIM
    q, k, v = jnp.split(x @ w_qkv, 3, axis=-1)
    q = _rope(q.reshape(b, s, 2 * h, dh), cos, sin).reshape(b, s, h, 2, dh) * (dh ** -0.5)
    k = _rope(k.reshape(b, s, 2 * h, dh), cos, sin).reshape(b, s, h, 2, dh)
    v = v.reshape(b, s, h, 2 * dh)
    lam_init = 0.8 - 0.6 * math.exp(-0.3 * layer_idx)
    lam = (jnp.exp(jnp.sum(lq1.astype(jnp.float32) * lk1.astype(jnp.float32)))
           - jnp.exp(jnp.sum(lq2.astype(jnp.float32) * lk2.astype(jnp.float32))) + lam_init)
    nb = s // Q_BLOCK
    q_blocks = q.reshape(b, nb, Q_BLOCK, h, 2, dh).swapaxes(0, 1)

    def one_block(qb):
        sc = jnp.einsum('bqhce,bkhce->bhcqk', qb, k).astype(jnp.float32)
        p = jax.nn.softmax(sc, axis=-1)
        a = p[:, :, 0] - lam * p[:, :, 1]
        return jnp.einsum('bhqk,bkhe->bqhe', a.astype(v.dtype), v)

    o = lax.map(one_block, q_blocks).swapaxes(0, 1).reshape(b, s, h, 2 * dh)
    o = _rms_norm(o, subln, DIFF_SUBLN_EPS) * (1.0 - lam_init)
    return o.reshape(b, s, h * 2 * dh) @ w_o


def _causal_conv(x, w, bias):
    kw = w.shape[0]
    s = x.shape[1]
    xp = jnp.pad(x, ((0, 0), (kw - 1, 0), (0, 0)))
    y = bias
    for j in range(kw):
        y = y + w[j] * xp[:, j:j + s]
    return y


def _rg_lru_direction(u, conv_w, conv_b, w_a, b_a, w_x, b_x, lam):
    b, s, c = u.shape
    xc = _causal_conv(u, conv_w, conv_b)
    xb = xc.reshape(b, s, LRU_BLOCKS, LRU_BLOCK_DIM)
    r = jax.nn.sigmoid((jnp.einsum('bsni,nij->bsnj', xb, w_a).reshape(b, s, c) + b_a).astype(jnp.float32))
    i = jax.nn.sigmoid((jnp.einsum('bsni,nij->bsnj', xb, w_x).reshape(b, s, c) + b_x).astype(jnp.float32))
    log_a = LRU_C * r * jax.nn.log_sigmoid(lam.astype(jnp.float32))
    a = jnp.exp(log_a)
    inp = jnp.sqrt(-jnp.expm1(2.0 * log_a)) * (i * xc.astype(jnp.float32))

    def combine(left, right):
        a_l, b_l = left
        a_r, b_r = right
        return a_l * a_r, a_r * b_l + b_r

    _, h = lax.associative_scan(combine, (a, inp), axis=1)
    return h


def _rglru_mixer(x, w_in, conv_w, conv_b, w_a, b_a, w_x, b_x, lam, w_out):
    gate, u = jnp.split(x @ w_in, 2, axis=-1)
    h_fwd = _rg_lru_direction(u, conv_w[0], conv_b[0], w_a[0], b_a[0], w_x[0], b_x[0], lam[0])
    h_bwd = jnp.flip(_rg_lru_direction(jnp.flip(u, axis=1), conv_w[1], conv_b[1], w_a[1], b_a[1],
                                       w_x[1], b_x[1], lam[1]), axis=1)
    y = jax.nn.gelu(gate.astype(jnp.float32), approximate=True) * (h_fwd + h_bwd)
    return y.astype(x.dtype) @ w_out


def _dilated_chain_attention(q, k, v, dilation, half):
    b, s, h, dh = q.shape
    n = s // dilation
    blk = half
    nb = -(-n // blk)
    pad = nb * blk - n

    def chains(t):
        return t.reshape(b, n, dilation, h, dh).transpose(0, 2, 3, 1, 4)

    qc = jnp.pad(chains(q), ((0, 0), (0, 0), (0, 0), (0, pad), (0, 0))).reshape(b, dilation, h, nb, blk, dh)

    def windows(t):
        tp = jnp.pad(chains(t), ((0, 0), (0, 0), (0, 0), (blk, blk + pad), (0, 0)))
        tp = tp.reshape(b, dilation, h, nb + 2, blk, dh)
        return jnp.concatenate([tp[:, :, :, :-2], tp[:, :, :, 1:-1], tp[:, :, :, 2:]], axis=4)

    kw, vw = windows(k), windows(v)
    qpos = jnp.arange(nb * blk).reshape(nb, blk)
    kpos = jnp.arange(nb)[:, None] * blk + jnp.arange(-blk, 2 * blk)[None, :]
    rel = kpos[:, None, :] - qpos[:, :, None]
    valid = (jnp.abs(rel) <= half) & (kpos[:, None, :] >= 0) & (kpos[:, None, :] < n)
    sc = jnp.einsum('bdhnqe,bdhnke->bdhnqk', qc, kw).astype(jnp.float32)
    sc = jnp.where(valid, sc, NEG_INF)
    lse = jax.nn.logsumexp(sc, axis=-1)
    p = jnp.exp(sc - lse[..., None])
    o = jnp.einsum('bdhnqk,bdhnke->bdhnqe', p.astype(v.dtype), vw)

    def unchain(t):
        t = t.reshape((b, dilation, h, nb * blk) + t.shape[5:])[:, :, :, :n]
        t = jnp.moveaxis(t, 3, 1)
        return t.reshape((b, s, h) + t.shape[4:])

    return unchain(o), unchain(lse)


def _dilated_mixer(x, w_qkv, w_o, cos, sin):
    b, s, _ = x.shape
    n_groups = len(DIL_GROUPS)
    qkv = (x @ w_qkv).reshape(b, s, n_groups, 3, DIL_HEADS, HEAD_DIM)
    q = _rope(qkv[:, :, :, 0], cos, sin) * (HEAD_DIM ** -0.5)
    k = _rope(qkv[:, :, :, 1], cos, sin)
    v = qkv[:, :, :, 2]
    outs, lses = [], []
    for g, (window, dilation) in enumerate(DIL_GROUPS):
        o, l = _dilated_chain_attention(q[:, :, g], k[:, :, g], v[:, :, g], dilation, window // (2 * dilation))
        outs.append(o.astype(jnp.float32))
        lses.append(l)
    wts = jax.nn.softmax(jnp.stack(lses, axis=0), axis=0)
    o = jnp.sum(wts[..., None] * jnp.stack(outs, axis=0), axis=0)
    return o.astype(x.dtype).reshape(b, s, DIL_WIDTH) @ w_o


def _conv_ffn(x, w_up, conv_w, conv_b, w_down):
    s = x.shape[1]
    g, u = jnp.split(x @ w_up, 2, axis=-1)
    half = FFN_CONV // 2
    gp = jnp.pad(g, ((0, 0), (half, half), (0, 0)))
    gc = conv_b
    for j in range(FFN_CONV):
        gc = gc + conv_w[j] * gp[:, j:j + s]
    act = jax.nn.gelu(gc.astype(jnp.float32), approximate=False).astype(x.dtype)
    return (act * u) @ w_down


def setup_inputs(seed: int = 0) -> dict:
    key = jax.random.key(seed)
    keys = iter(jax.random.split(key, 48))
    f32 = jnp.float32
    n_a, n_b, n_c, n_d = (_n_layers_of(m) for m in range(N_MIXERS))

    def dense(shape, fan_in):
        return jax.random.normal(next(keys), shape, f32) * fan_in ** -0.5

    def gain(shape):
        return 1.0 + 0.05 * jax.random.normal(next(keys), shape, f32)

    def small(shape, scale=0.02):
        return scale * jax.random.normal(next(keys), shape, f32)

    x = jax.random.normal(next(keys), (BATCH, SEQ, D_MODEL), f32)
    a_c = jax.random.uniform(next(keys), (n_c, 2, LRU_WIDTH), f32, 0.9, 0.999)
    base = a_c ** (1.0 / LRU_C)
    lru_lambda = jnp.log(base) - jnp.log1p(-base)
    return {
        "x": x,
        "positions": jnp.arange(SEQ, dtype=jnp.int32),
        "mix_norm": gain((DEPTH, D_MODEL)),
        "pool_w": dense((n_a, len(POOL_WINDOWS), POOL_GROUP, POOL_GROUP), POOL_GROUP),
        "pool_scale": gain((n_a, D_MODEL)),
        "diff_w_qkv": dense((n_b, D_MODEL, 3 * D_MODEL), D_MODEL),
        "diff_lam_q1": small((n_b, HEAD_DIM), 0.1),
        "diff_lam_k1": small((n_b, HEAD_DIM), 0.1),
        "diff_lam_q2": small((n_b, HEAD_DIM), 0.1),
        "diff_lam_k2": small((n_b, HEAD_DIM), 0.1),
        "diff_subln": gain((n_b, 2 * HEAD_DIM)),
        "diff_w_o": dense((n_b, D_MODEL, D_MODEL), D_MODEL),
        "lru_w_in": dense((n_c, D_MODEL, 2 * LRU_WIDTH), D_MODEL),
        "lru_conv_w": dense((n_c, 2, LRU_CONV, LRU_WIDTH), LRU_CONV),
        "lru_conv_b": small((n_c, 2, LRU_WIDTH)),
        "lru_w_a": dense((n_c, 2, LRU_BLOCKS, LRU_BLOCK_DIM, LRU_BLOCK_DIM), LRU_BLOCK_DIM),
        "lru_b_a": small((n_c, 2, LRU_WIDTH)),
        "lru_w_x": dense((n_c, 2, LRU_BLOCKS, LRU_BLOCK_DIM, LRU_BLOCK_DIM), LRU_BLOCK_DIM),
        "lru_b_x": small((n_c, 2, LRU_WIDTH)),
        "lru_lambda": lru_lambda,
        "lru_w_out": dense((n_c, LRU_WIDTH, D_MODEL), LRU_WIDTH),
        "dil_w_qkv": dense((n_d, D_MODEL, len(DIL_GROUPS) * 3 * DIL_WIDTH), D_MODEL),
        "dil_w_o": dense((n_d, DIL_WIDTH, D_MODEL), DIL_WIDTH),
        "ffn_norm": gain((DEPTH, D_MODEL)),
        "ffn_w_up": dense((DEPTH, D_MODEL, 2 * D_FF), D_MODEL),
        "ffn_conv_w": dense((DEPTH, FFN_CONV, D_FF), FFN_CONV),
        "ffn_conv_b": small((DEPTH, D_FF)),
        "ffn_w_down": dense((DEPTH, D_FF, D_MODEL), D_FF),
        "final_norm": gain((D_MODEL,)),
    }


def reference(x, positions, mix_norm, pool_w, pool_scale, diff_w_qkv, diff_lam_q1, diff_lam_k1,
              diff_lam_q2, diff_lam_k2, diff_subln, diff_w_o, lru_w_in, lru_conv_w, lru_conv_b,
              lru_w_a, lru_b_a, lru_w_x, lru_b_x, lru_lambda, lru_w_out, dil_w_qkv, dil_w_o,
              ffn_norm, ffn_w_up, ffn_conv_w, ffn_conv_b, ffn_w_down, final_norm):
    cos, sin = _rope_tables(positions, HEAD_DIM)
    h = x
    for i in range(DEPTH):
        m, j = i % N_MIXERS, i // N_MIXERS
        hn = _rms_norm(h, mix_norm[i])
        if m == 0:
            y = _pool_mixer(hn, pool_w[j], pool_scale[j])
        elif m == 1:
            y = _diff_attention(hn, diff_w_qkv[j], diff_lam_q1[j], diff_lam_k1[j], diff_lam_q2[j],
                                diff_lam_k2[j], diff_subln[j], diff_w_o[j], cos, sin, i)
        elif m == 2:
            y = _rglru_mixer(hn, lru_w_in[j], lru_conv_w[j], lru_conv_b[j], lru_w_a[j], lru_b_a[j],
                             lru_w_x[j], lru_b_x[j], lru_lambda[j], lru_w_out[j])
        else:
            y = _dilated_mixer(hn, dil_w_qkv[j], dil_w_o[j], cos, sin)
        h = h + y
        h = h + _conv_ffn(_rms_norm(h, ffn_norm[i]), ffn_w_up[i], ffn_conv_w[i], ffn_conv_b[i], ffn_w_down[i])
    return _rms_norm(h, final_norm)
```

```cpp
#include <hip/hip_runtime.h>
#include <hip/hip_cooperative_groups.h>
#include <cstdio>
#include <cstdint>
namespace cg = cooperative_groups;

#define LAS __attribute__((address_space(3)))
typedef unsigned short bf16_t;
typedef short bf16x8 __attribute__((ext_vector_type(8)));
typedef short s16x4 __attribute__((ext_vector_type(4)));
typedef float f32x4 __attribute__((ext_vector_type(4)));
typedef float f32x2 __attribute__((ext_vector_type(2)));
typedef float f32x16 __attribute__((ext_vector_type(16)));
typedef unsigned u32x4 __attribute__((ext_vector_type(4)));
typedef unsigned u32x2 __attribute__((ext_vector_type(2)));

constexpr int NT = 512;
constexpr int LDS_BYTES = 147456;
constexpr int M = 32768, D = 1024, S = 2048, NB = 16, DFF = 2816;
constexpr float QSCALE = 0.125f * 1.4426950408889634f;

__device__ __forceinline__ unsigned f2bf(float f) { unsigned u = __builtin_bit_cast(unsigned, f); return (u + 0x7fffu + ((u >> 16) & 1u)) >> 16; }
__device__ __forceinline__ unsigned pk2(float lo, float hi) { return f2bf(lo) | (f2bf(hi) << 16); }
__device__ __forceinline__ float bf2f(unsigned short h) { return __builtin_bit_cast(float, (unsigned)h << 16); }
__device__ __forceinline__ float bflo(unsigned w) { return __builtin_bit_cast(float, w << 16); }
__device__ __forceinline__ float bfhi(unsigned w) { return __builtin_bit_cast(float, w & 0xffff0000u); }
__device__ __forceinline__ float wave_sum(float v) {
#pragma unroll
    for (int o = 1; o < 64; o <<= 1) v += __shfl_xor(v, o);
    return v;
}
__device__ __forceinline__ int opq(int v) { asm volatile("" : "+v"(v)); return v; }
__device__ __forceinline__ int crow(int r, int hi) { return (r & 3) + 8 * (r >> 2) + 4 * hi; }
__device__ __forceinline__ f32x2 gelu_pk(f32x2 v) {
    const f32x2 av = __builtin_elementwise_abs(v), d = av * 0.2316418882f + 1.0f;
    f32x2 t; t.x = __builtin_amdgcn_rcpf(d.x); t.y = __builtin_amdgcn_rcpf(d.y);
    f32x2 q = t * 0.5307027145f + (-0.7265760135f); q = q * t + 0.7107068705f; q = q * t + (-0.142248368f); q = q * t + 0.127414796f; q = q * t;
    const f32x2 s = (v * v) * (-0.72134752044f);
    f32x2 e; e.x = __builtin_amdgcn_exp2f(s.x); e.y = __builtin_amdgcn_exp2f(s.y);
    const f32x2 m = v * (q * e), r = v - m;
    f32x2 o; o.x = v.x < 0.f ? m.x : r.x; o.y = v.y < 0.f ? m.y : r.y; return o;
}

namespace pg8 {
constexpr int BM = 256, BK = 64, HALF = 128, HTB = HALF * BK * 2, STAGE_BYTES = 8 * HTB, NXCD = 8, WGM = 8;
__device__ __forceinline__ int lds_byte(int r, int c) { const int st = (r >> 4) * 2 + (c >> 5), rr = r & 15, cc = c & 31, ob = rr * 64 + cc * 2; return st * 1024 + (ob ^ (((ob >> 9) & 1) << 5)); }
__device__ __forceinline__ void stage_rc(int b, int& R, int& C) { const int st = b / 1024, sb = b % 1024, swz = sb ^ (((sb >> 9) & 1) << 5); R = (st >> 1) * 16 + swz / 64; C = (st & 1) * 32 + (swz % 64) / 2; }
__device__ __forceinline__ int perm32(int rho) { const int n = rho >> 4, i = rho & 15; return 8 * (i >> 2) + 4 * n + (i & 3); }

struct Unit { int pm, pn; };
struct Gemm { const bf16_t* A; const bf16_t* Bt; int K; int lda, ldb; int amode, bmode; int nM, nN; };
__device__ __forceinline__ size_t map_base(int mode, int p, int other, int ld) {
    if (mode == 1) { const int b = p >> 3, q = p & 7, r = q >> 1, mu = q & 1; return (size_t)(b * 2048 + 1024 * mu + r) * ld; }
    if (mode == 2) { const int b = p >> 3, rho = p & 7; return (size_t)(b * 2048 + 2 * rho) * ld; }
    if (mode == 3) return (size_t)p * 256 * ld + (size_t)other * 256;
    return (size_t)p * 256 * ld;
}
__device__ __forceinline__ int map_rs(int mode, int ld) { return mode == 1 ? 4 * ld : (mode == 2 ? 16 * ld : ld); }
__device__ __forceinline__ int map_hs(int mode, int ld) { return mode == 1 ? 512 * ld : (mode == 2 ? ld : 128 * ld); }

struct StaticOrder {
    int nM, nN, nwg, G, c;
    __device__ void init(int nM_, int nN_, int G_, int c_) { nM = nM_; nN = nN_; nwg = nM * nN; G = G_; c = c_; }
    __device__ bool next(int i, Unit& u) const {
        const long L = (long)i * G + c; if (L >= nwg) return false;
        int wgid = (int)L; { const int q = nwg / NXCD, r = nwg % NXCD, xcd = wgid % NXCD, off = wgid / NXCD; wgid = (xcd < r ? xcd * (q + 1) : r * (q + 1) + (xcd - r) * q) + off; }
        const int nig = WGM * nN, gid = wgid / nig, fm = gid * WGM, gsz = (nM - fm) < WGM ? (nM - fm) : WGM;
        u.pm = fm + ((wgid % nig) % gsz); u.pn = (wgid % nig) / gsz; return true;
    }
};

__device__ __forceinline__ unsigned cvt_pk_bf16(float lo, float hi) { unsigned r; asm volatile("v_cvt_pk_bf16_f32 %0, %1, %2" : "=v"(r) : "v"(lo), "v"(hi)); return r; }

struct EpiPlain {
    static constexpr bool PERM = true;
    bf16_t* O; size_t ldc;
    __device__ __forceinline__ void operator()(const f32x4 (&acc)[2][2][4][2], const Unit& u, int wr, int wc, int fr, int fq) const {
        const int row0 = u.pm * BM + wr * 64 + fr, col0 = u.pn * BM + wc * 32 + 8 * fq;
#pragma unroll
        for (int ai = 0; ai < 2; ++ai)
#pragma unroll
            for (int m = 0; m < 4; ++m) { bf16_t* rowp = O + (size_t)(row0 + ai * HALF + m * 16) * ldc + col0;
#pragma unroll
                for (int bj = 0; bj < 2; ++bj) { const f32x4 v0 = acc[ai][bj][m][0], v1 = acc[ai][bj][m][1];
                    u32x4 w; w.x = cvt_pk_bf16(v0[0], v0[1]); w.y = cvt_pk_bf16(v0[2], v0[3]); w.z = cvt_pk_bf16(v1[0], v1[1]); w.w = cvt_pk_bf16(v1[2], v1[3]);
                    *(u32x4*)(rowp + bj * HALF) = w; } }
    }
};
struct EpiResid {
    static constexpr bool PERM = false;
    const float* resid; float* out; const float* cs;
    __device__ __forceinline__ void operator()(const f32x4 (&acc)[2][2][4][2], const Unit& u, int wr, int wc, int fr, int fq) const {
        const int col0 = u.pn * BM + wc * 32 + 4 * fq;
        f32x4 sv[2][2];
#pragma unroll
        for (int bj = 0; bj < 2; ++bj)
#pragma unroll
            for (int n = 0; n < 2; ++n) sv[bj][n] = cs ? *(const f32x4*)(cs + col0 + bj * HALF + n * 16) : (f32x4){1.f, 1.f, 1.f, 1.f};
#pragma unroll
        for (int ai = 0; ai < 2; ++ai)
#pragma unroll
            for (int m = 0; m < 4; ++m) { const size_t off = (size_t)(u.pm * BM + ai * HALF + wr * 64 + m * 16 + fr) * D + col0;
#pragma unroll
                for (int bj = 0; bj < 2; ++bj)
#pragma unroll
                    for (int n = 0; n < 2; ++n) { const f32x4 bs = *(const f32x4*)(resid + off + bj * HALF + n * 16);
                        *(f32x4*)(out + off + bj * HALF + n * 16) = bs + acc[ai][bj][m][n] * sv[bj][n]; }
                asm volatile("" ::: "memory"); }
    }
};
struct EpiRope {
    static constexpr bool PERM = true;
    bf16_t* O; const float* cosT; const float* sinT; int mode; float qscale;
    __device__ __forceinline__ void operator()(const f32x4 (&acc)[2][2][4][2], const Unit& u, int wr, int wc, int fr, int fq) const {
        const int colt = u.pn * BM; const float sc = (colt < 1024) ? qscale : 1.f;
#pragma unroll
        for (int ai = 0; ai < 2; ++ai)
#pragma unroll
            for (int m = 0; m < 4; ++m) { const int row = u.pm * BM + ai * HALF + wr * 64 + m * 16 + fr; const int jj = row & 2047;
                int t = jj; if (mode == 1) t = 4 * (jj & 511) + (jj >> 9); else if (mode == 2) t = 16 * (jj & 127) + (jj >> 7);
#pragma unroll
                for (int bj = 0; bj < 2; ++bj) { const int col8 = colt + bj * HALF + wc * 32 + 8 * fq; const int hb = col8 & ~63, i4 = ((col8 & 63) >> 3) * 4;
                    const f32x4 c4 = *(const f32x4*)(cosT + t * 32 + i4), s4 = *(const f32x4*)(sinT + t * 32 + i4);
                    const f32x4 x1 = acc[ai][bj][m][0], x2 = acc[ai][bj][m][1];
                    const f32x4 o1 = (x1 * c4 - x2 * s4) * sc, o2 = (x2 * c4 + x1 * s4) * sc;
                    u32x2 w1, w2; w1.x = cvt_pk_bf16(o1[0], o1[1]); w1.y = cvt_pk_bf16(o1[2], o1[3]); w2.x = cvt_pk_bf16(o2[0], o2[1]); w2.y = cvt_pk_bf16(o2[2], o2[3]);
                    bf16_t* p = O + (size_t)row * 2048 + hb + i4;
                    *(u32x2*)p = w1; *(u32x2*)(p + 32) = w2; } }
    }
};

template <class Epi, bool ALIGN_EPI = true>
__device__ __forceinline__ void gemm_phase(LAS unsigned char* lds, const Gemm g, const Epi& E) {
    const int tid = opq((int)threadIdx.x), wid = __builtin_amdgcn_readfirstlane(tid >> 6), lane = tid & 63, wr = wid >> 2, wc = wid & 3, fr = lane & 15, fq = lane >> 4;
    StaticOrder S; S.init(g.nM, g.nN, (int)gridDim.x, (int)blockIdx.x);
    const int K = g.K, nt = K / BK;
    const int a_rs = map_rs(g.amode, g.lda), b_rs = map_rs(g.bmode, g.ldb);
    unsigned voffA[2], voffB[2];
#pragma unroll
    for (int i = 0; i < 2; ++i) { int R, C; stage_rc(tid * 16 + i * 8192, R, C); const int Rb = Epi::PERM ? ((R & ~31) + perm32(R & 31)) : R;
        voffA[i] = (unsigned)(R * a_rs + C) * 2u; voffB[i] = (unsigned)(Rb * b_rs + C) * 2u; }
    const size_t kstep = (size_t)(BK * 2);
    const size_t hstepA = (size_t)map_hs(g.amode, g.lda) * 2, hstepB = (size_t)map_hs(g.bmode, g.ldb) * 2;
    const unsigned ldsw = (unsigned)wid * 1024u;
    const int aoff = lds_byte(wr * 64 + fr, fq * 8), boff = lds_byte(wc * 32 + fr, fq * 8);
#define PG8_SA(b, h) (((b) * 2 + (h)) * HTB)
#define PG8_SB(b, h) ((4 + (b) * 2 + (h)) * HTB)
#define PG8_STAGE(bufoff, gbase, voff) do { _Pragma("unroll") for (int _i = 0; _i < 2; ++_i) \
        __builtin_amdgcn_global_load_lds((const unsigned*)((const char*)(gbase) + (voff)[_i]), (LAS unsigned*)(lds + (bufoff) + ldsw + _i * 8192), 16, 0, 0); } while (0)
#define PG8_LDA(dst, b, h) do { _Pragma("unroll") for (int m = 0; m < 4; ++m) _Pragma("unroll") for (int k = 0; k < 2; ++k) dst[m][k] = *(const LAS bf16x8*)(lds + PG8_SA(b, h) + aoff + m * 2048 + k * 1024); } while (0)
#define PG8_LDB(dst, b, h) do { _Pragma("unroll") for (int n = 0; n < 2; ++n) _Pragma("unroll") for (int k = 0; k < 2; ++k) dst[n][k] = *(const LAS bf16x8*)(lds + PG8_SB(b, h) + boff + n * 2048 + k * 1024); } while (0)
#define PG8_MMA(ai, bj, At, Bt) do { __builtin_amdgcn_s_setprio(1); _Pragma("unroll") for (int m = 0; m < 4; ++m) _Pragma("unroll") for (int n = 0; n < 2; ++n) _Pragma("unroll") for (int k = 0; k < 2; ++k) \
        acc[ai][bj][m][n] = __builtin_amdgcn_mfma_f32_16x16x32_bf16(Bt[n][k], At[m][k], acc[ai][bj][m][n], 0, 0, 0); __builtin_amdgcn_s_setprio(0); } while (0)
#define PG8_WAIT_V(n) asm volatile("s_waitcnt vmcnt(" #n ")" ::: "memory")
#define PG8_WAIT_L(n) asm volatile("s_waitcnt lgkmcnt(" #n ")" ::: "memory")
#define PG8_BAR __builtin_amdgcn_s_barrier()
#define PG8_SCHED __builtin_amdgcn_sched_barrier(0)
    Unit cur, nxt; int ui = 0;
    if (!S.next(0, cur)) return;
    f32x4 acc[2][2][4][2];
#pragma unroll
    for (int a = 0; a < 2; ++a)
#pragma unroll
        for (int b = 0; b < 2; ++b)
#pragma unroll
            for (int m = 0; m < 4; ++m)
#pragma unroll
                for (int n = 0; n < 2; ++n) acc[a][b][m][n] = (f32x4){0.f, 0.f, 0.f, 0.f};
    bf16x8 At[4][2], B0[2][2], B1[2][2];
    const char* cA = (const char*)g.A + map_base(g.amode, cur.pm, cur.pn, g.lda) * 2; const char* cB = (const char*)g.Bt + map_base(g.bmode, cur.pn, cur.pm, g.ldb) * 2;
    PG8_STAGE(PG8_SB(0, 0), cB, voffB); PG8_STAGE(PG8_SB(0, 1), cB + hstepB, voffB); PG8_STAGE(PG8_SA(0, 0), cA, voffA); PG8_STAGE(PG8_SA(0, 1), cA + hstepA, voffA);
    if (wr == 1) PG8_BAR;
    PG8_WAIT_V(2); PG8_BAR;
    PG8_STAGE(PG8_SB(1, 0), cB + kstep, voffB); PG8_STAGE(PG8_SA(1, 0), cA + kstep, voffA); PG8_STAGE(PG8_SB(1, 1), cB + hstepB + kstep, voffB);
    PG8_WAIT_V(6); PG8_BAR;
    for (;;) {
        const bool has_next = S.next(ui + 1, nxt);
        const char* nA = has_next ? (const char*)g.A + map_base(g.amode, nxt.pm, nxt.pn, g.lda) * 2 : cA; const char* nB = has_next ? (const char*)g.Bt + map_base(g.bmode, nxt.pn, nxt.pm, g.ldb) * 2 : cB;
        for (int t = 0; t < nt; t += 2) {
            const bool last = (t == nt - 2);
            const char* a1 = cA + (size_t)(t + 1) * kstep;
            const char* a2 = last ? nA : cA + (size_t)(t + 2) * kstep; const char* b2 = last ? nB : cB + (size_t)(t + 2) * kstep;
            const char* a3 = a2 + kstep; const char* b3 = b2 + kstep;
            PG8_LDB(B0, 0, 0); PG8_LDB(B1, 0, 1); PG8_SCHED; PG8_LDA(At, 0, 0); PG8_STAGE(PG8_SA(1, 1), a1 + hstepA, voffA);
            PG8_WAIT_V(8); PG8_WAIT_L(0); PG8_BAR; PG8_MMA(0, 0, At, B0); PG8_MMA(0, 1, At, B1); PG8_BAR; PG8_SCHED;
            PG8_LDA(At, 0, 1); PG8_STAGE(PG8_SB(0, 0), b2, voffB); PG8_STAGE(PG8_SB(0, 1), b2 + hstepB, voffB); PG8_STAGE(PG8_SA(0, 0), a2, voffA);
            PG8_WAIT_V(8); PG8_WAIT_L(0); PG8_BAR; PG8_MMA(1, 0, At, B0); PG8_MMA(1, 1, At, B1); PG8_BAR; PG8_SCHED;
            PG8_LDB(B0, 1, 0); PG8_LDB(B1, 1, 1); PG8_SCHED; PG8_LDA(At, 1, 0); PG8_STAGE(PG8_SA(0, 1), a2 + hstepA, voffA);
            PG8_WAIT_V(8); PG8_WAIT_L(0); PG8_BAR; PG8_MMA(0, 0, At, B0); PG8_MMA(0, 1, At, B1); PG8_BAR; PG8_SCHED;
            PG8_LDA(At, 1, 1); PG8_STAGE(PG8_SB(1, 0), b3, voffB); PG8_STAGE(PG8_SB(1, 1), b3 + hstepB, voffB); PG8_STAGE(PG8_SA(1, 0), a3, voffA);
            PG8_WAIT_V(8); PG8_WAIT_L(0); PG8_BAR; PG8_MMA(1, 0, At, B0); PG8_MMA(1, 1, At, B1); PG8_BAR; PG8_SCHED;
        }
        if constexpr (ALIGN_EPI) { if (wr == 0) PG8_BAR; }
        E(acc, cur, wr, wc, fr, fq);
        if (!has_next) break;
#pragma unroll
        for (int a = 0; a < 2; ++a)
#pragma unroll
            for (int b = 0; b < 2; ++b)
#pragma unroll
                for (int m = 0; m < 4; ++m)
#pragma unroll
                    for (int n = 0; n < 2; ++n) acc[a][b][m][n] = (f32x4){0.f, 0.f, 0.f, 0.f};
        cur = nxt; cA = nA; cB = nB; ++ui;
        if constexpr (ALIGN_EPI) { if (wr == 1) PG8_BAR; }
    }
    PG8_WAIT_V(0);
    if constexpr (!ALIGN_EPI) { if (wr == 0) PG8_BAR; }
    PG8_BAR;
#undef PG8_SA
#undef PG8_SB
#undef PG8_STAGE
#undef PG8_LDA
#undef PG8_LDB
#undef PG8_MMA
#undef PG8_WAIT_V
#undef PG8_WAIT_L
#undef PG8_BAR
#undef PG8_SCHED
}
}

constexpr size_t MiB = 1u << 20;
constexpr size_t W_POOL = 0, W_DQK = 1 * MiB, W_DV = 5 * MiB, W_DO = 7 * MiB, W_LIN = 9 * MiB, W_LG = 13 * MiB, W_LOUT = 14 * MiB, W_XQKV = 16 * MiB, W_XO = 34 * MiB,
                 W_UP = 36 * MiB, W_DOWN = 47 * MiB, T_COS = 53 * MiB, T_SIN = 53 * MiB + 256 * 1024, T_RSTD = 54 * MiB, T_AGG = 55 * MiB, T_LSE = 71 * MiB,
                 WS_XN = 76 * MiB, WS_SCR = 140 * MiB, WS_END = 512 * MiB;

struct Args { const float* in[29]; float* out; unsigned char* ws; };
enum { I_X = 0, I_POS, I_MIXNORM, I_POOLW, I_POOLS, I_DQKV, I_LQ1, I_LK1, I_LQ2, I_LK2, I_SUBLN, I_DWO, I_LWIN, I_LCW, I_LCB, I_LWA, I_LBA, I_LWX, I_LBX, I_LLAM, I_LWOUT,
       I_XQKV, I_XWO, I_FNORM, I_FUP, I_FCW, I_FCB, I_FDOWN, I_FINAL };

__device__ __forceinline__ int ropeperm(int n) { const int d = n & 63; const int p = d < 32 ? 8 * (d >> 2) + (d & 3) : 8 * ((d - 32) >> 2) + 4 + (d & 3); return (n & ~63) + p; }
__device__ __forceinline__ void transpose_mat(const float* W, int K, int N, int ldn, int c0, bf16_t* WT, int rmode, LAS float* scr, int gw, int NGW, int lane_in) {
    const int lane = opq(lane_in);
    const int nblk = N / 32, items = (K / 64) * nblk;
    for (int item = gw; item < items; item += NGW) {
        const int kb = item / nblk, nb = item % nblk, k0 = 64 * kb, n0 = 32 * nb;
#pragma unroll 8
        for (int i = 0; i < 32; ++i) { const int kk = 2 * i + (lane >> 5); scr[kk * 33 + (lane & 31)] = W[(size_t)(k0 + kk) * ldn + c0 + n0 + (lane & 31)]; }
        asm volatile("s_waitcnt lgkmcnt(0)" ::: "memory");
        const int c = lane & 7;
#pragma unroll
        for (int j = 0; j < 4; ++j) { const int n = (lane >> 3) + 8 * j; const LAS float* s = scr + (8 * c) * 33 + n;
            u32x4 o; o.x = pk2(s[0 * 33], s[1 * 33]); o.y = pk2(s[2 * 33], s[3 * 33]); o.z = pk2(s[4 * 33], s[5 * 33]); o.w = pk2(s[6 * 33], s[7 * 33]);
            int dn = n0 + n;
            if (rmode == 1) dn = ropeperm(dn);
            else if (rmode == 2) { const int gq = dn / 3072, nl = dn % 3072; dn = gq * 3072 + (nl < 2048 ? ropeperm(nl) : nl); }
            *(u32x4*)(WT + (size_t)dn * K + k0 + 8 * c) = o; }
        asm volatile("s_waitcnt lgkmcnt(0)" ::: "memory");
    }
}
__device__ __forceinline__ void convert_ffn(const Args& a, int layer, LAS float* scr, int gw, int NGW, int lane) {
    transpose_mat(a.in[I_FUP] + (size_t)layer * D * 2 * DFF, D, 2 * DFF, 2 * DFF, 0, (bf16_t*)(a.ws + W_UP), 0, scr, gw, NGW, lane);
    transpose_mat(a.in[I_FDOWN] + (size_t)layer * DFF * D, DFF, D, D, 0, (bf16_t*)(a.ws + W_DOWN), 0, scr, gw, NGW, lane);
}
__device__ __forceinline__ void norm_rows(const float* src, const float* gain, bf16_t* dst, int gw, int NGW, int lane_in) {
    const int lane = opq(lane_in);
    f32x4 gv[4];
#pragma unroll
    for (int j = 0; j < 4; ++j) gv[j] = ((const f32x4*)gain)[lane + 64 * j];
    for (int m = gw; m < M; m += NGW) {
        const f32x4* xr = (const f32x4*)(src + (size_t)m * D) + lane;
        f32x4 v[4]; float s = 0.f;
#pragma unroll
        for (int j = 0; j < 4; ++j) { v[j] = xr[64 * j]; s += (v[j].x * v[j].x + v[j].y * v[j].y) + (v[j].z * v[j].z + v[j].w * v[j].w); }
        const float r = 1.0f / sqrtf(wave_sum(s) * (1.f / D) + 1e-6f);
        u32x2* o8 = (u32x2*)(dst + (size_t)m * D) + lane;
#pragma unroll
        for (int j = 0; j < 4; ++j) { u32x2 w; w.x = pk2(v[j].x * r * gv[j].x, v[j].y * r * gv[j].y); w.y = pk2(v[j].z * r * gv[j].z, v[j].w * r * gv[j].w); o8[64 * j] = w; }
    }
}

constexpr int DA_KP = 272, DA_VP = 144, DA_KOFF = 0, DA_VOFF = 64 * DA_KP, DA_XOFF = 40960;
__device__ __forceinline__ void diff_attn_phase(unsigned char* ldsg, const bf16_t* QK, const bf16_t* Vt, bf16_t* O, float lam, float lam_init, const float* subln) {
    LAS unsigned char* lds = (LAS unsigned char*)ldsg;
    const int tid = opq((int)threadIdx.x), wave = __builtin_amdgcn_readfirstlane(tid >> 6), lane = tid & 63, qg = wave & 3, c = wave >> 2, l31 = lane & 31, hi = lane >> 5;
    for (int unit = blockIdx.x; unit < 2048; unit += gridDim.x) {
        const int b = unit >> 7, hh = (unit >> 4) & 7, qb = unit & 15;
        const size_t rowb = (size_t)b * S;
        const bf16_t* qp = QK + (rowb + qb * 128 + qg * 32 + l31) * 2048 + 128 * hh + 64 * c + 8 * hi;
        bf16x8 qf[4];
#pragma unroll
        for (int ks = 0; ks < 4; ++ks) qf[ks] = *(const bf16x8*)(qp + 16 * ks);
        const bf16_t* kg = QK + rowb * 2048 + 1024 + 128 * hh;
        const bf16_t* vg = Vt + (size_t)(128 * hh) * M + rowb;
        const bf16_t* ksrc[2]; const bf16_t* vsrc[2]; int kdst[2], vdst[2];
#pragma unroll
        for (int i = 0; i < 2; ++i) { const int id = tid + 512 * i;
            ksrc[i] = kg + (size_t)(id >> 4) * 2048 + (id & 15) * 8; kdst[i] = DA_KOFF + (id >> 4) * DA_KP + (id & 15) * 16;
            vsrc[i] = vg + (size_t)(id >> 3) * M + (id & 7) * 8;     vdst[i] = DA_VOFF + (id >> 3) * DA_VP + (id & 7) * 16; }
        u32x4 kr[2], vr[2];
#pragma unroll
        for (int i = 0; i < 2; ++i) { kr[i] = *(const u32x4*)(ksrc[i]); vr[i] = *(const u32x4*)(vsrc[i]); }
        __syncthreads();
#pragma unroll
        for (int i = 0; i < 2; ++i) { *(LAS u32x4*)(lds + kdst[i]) = kr[i]; *(LAS u32x4*)(lds + vdst[i]) = vr[i]; }
        __syncthreads();
        f32x16 ot[4];
#pragma unroll
        for (int dt = 0; dt < 4; ++dt)
#pragma unroll
            for (int r = 0; r < 16; ++r) ot[dt][r] = 0.f;
        float mrun = -1e30f, lrun = 0.f;
        const LAS unsigned char* kbase = lds + DA_KOFF + l31 * DA_KP + (64 * c + 8 * hi) * 2;
        const LAS unsigned char* vbase = lds + DA_VOFF + l31 * DA_VP + (4 * hi) * 2;
        for (int kt = 0; kt < 32; ++kt) {
            if (kt + 1 < 32) {
#pragma unroll
                for (int i = 0; i < 2; ++i) { kr[i] = *(const u32x4*)(ksrc[i] + (size_t)(kt + 1) * 64 * 2048); vr[i] = *(const u32x4*)(vsrc[i] + (kt + 1) * 64); }
            }
            f32x16 st[2];
#pragma unroll
            for (int t2 = 0; t2 < 2; ++t2) {
#pragma unroll
                for (int r = 0; r < 16; ++r) st[t2][r] = 0.f;
#pragma unroll
                for (int ks = 0; ks < 4; ++ks) { const bf16x8 kf = *(const LAS bf16x8*)(kbase + t2 * 32 * DA_KP + ks * 32);
                    st[t2] = __builtin_amdgcn_mfma_f32_32x32x16_bf16(kf, qf[ks], st[t2], 0, 0, 0); }
            }
            float mx = st[0][0];
#pragma unroll
            for (int r = 0; r < 16; ++r) { mx = fmaxf(mx, st[0][r]); mx = fmaxf(mx, st[1][r]); }
            mx = fmaxf(mx, __shfl_xor(mx, 32));
            const float mnew = fmaxf(mrun, mx);
            if (__any(mnew > mrun)) {
                const float alpha = __builtin_amdgcn_exp2f(mrun - mnew);
                lrun *= alpha;
#pragma unroll
                for (int dt = 0; dt < 4; ++dt)
#pragma unroll
                    for (int r = 0; r < 16; ++r) ot[dt][r] *= alpha;
                mrun = mnew;
            }
            float ps = 0.f;
#pragma unroll
            for (int t2 = 0; t2 < 2; ++t2)
#pragma unroll
                for (int r = 0; r < 16; ++r) { const float p = __builtin_amdgcn_exp2f(st[t2][r] - mrun); st[t2][r] = p; ps += p; }
            lrun += ps;
            bf16x8 pb[4];
#pragma unroll
            for (int s = 0; s < 4; ++s) { const int t2 = s >> 1, r0 = 8 * (s & 1);
                u32x4 w; w.x = pg8::cvt_pk_bf16(st[t2][r0], st[t2][r0 + 1]); w.y = pg8::cvt_pk_bf16(st[t2][r0 + 2], st[t2][r0 + 3]); w.z = pg8::cvt_pk_bf16(st[t2][r0 + 4], st[t2][r0 + 5]); w.w = pg8::cvt_pk_bf16(st[t2][r0 + 6], st[t2][r0 + 7]);
                pb[s] = __builtin_bit_cast(bf16x8, w); }
#pragma unroll
            for (int dt = 0; dt < 4; ++dt)
#pragma unroll
                for (int s = 0; s < 4; ++s) { const LAS unsigned char* vp = vbase + dt * 32 * DA_VP + (32 * (s >> 1) + 16 * (s & 1)) * 2;
                    const s16x4 lo = *(const LAS s16x4*)vp, hi4 = *(const LAS s16x4*)(vp + 16);
                    const bf16x8 vf = (bf16x8){lo[0], lo[1], lo[2], lo[3], hi4[0], hi4[1], hi4[2], hi4[3]};
                    ot[dt] = __builtin_amdgcn_mfma_f32_32x32x16_bf16(vf, pb[s], ot[dt], 0, 0, 0); }
            __syncthreads();
            if (kt + 1 < 32) {
#pragma unroll
                for (int i = 0; i < 2; ++i) { *(LAS u32x4*)(lds + kdst[i]) = kr[i]; *(LAS u32x4*)(lds + vdst[i]) = vr[i]; }
            }
            __syncthreads();
        }
        const float ltot = lrun + __shfl_xor(lrun, 32);
        const float inv = 1.0f / ltot;
        LAS float* X = (LAS float*)(lds + DA_XOFF) + (qg * 64) * 64 + lane;
        if (c == 1) {
#pragma unroll
            for (int dt = 0; dt < 4; ++dt)
#pragma unroll
                for (int r = 0; r < 16; ++r) X[(dt * 16 + r) * 64] = ot[dt][r] * inv;
        }
        __syncthreads();
        if (c == 0) {
            float ss = 0.f;
#pragma unroll
            for (int dt = 0; dt < 4; ++dt)
#pragma unroll
                for (int r = 0; r < 16; ++r) { const float o = ot[dt][r] * inv - lam * X[(dt * 16 + r) * 64]; ot[dt][r] = o; ss += o * o; }
            ss += __shfl_xor(ss, 32);
            const float rs = (1.0f / sqrtf(ss * (1.f / 128.f) + 1e-5f)) * (1.0f - lam_init);
            bf16_t* op = O + (rowb + qb * 128 + qg * 32 + l31) * D + 128 * hh;
#pragma unroll
            for (int dt = 0; dt < 4; ++dt)
#pragma unroll
                for (int g4 = 0; g4 < 4; ++g4) { const int d0 = 32 * dt + 8 * g4 + 4 * hi; const f32x4 sg = *(const f32x4*)(subln + d0);
                    u32x2 w; w.x = pk2(ot[dt][4 * g4] * rs * sg[0], ot[dt][4 * g4 + 1] * rs * sg[1]); w.y = pk2(ot[dt][4 * g4 + 2] * rs * sg[2], ot[dt][4 * g4 + 3] * rs * sg[3]);
                    *(u32x2*)(op + d0) = w; }
        }
    }
    __syncthreads();
}

__device__ __forceinline__ void dil_attn_phase(int gi, const bf16_t* QKg, const bf16_t* Vtg, float* Oacc, float* LSE, bf16_t* Ofin, int gw, int NGW, int lane_in) {
    const int lane = opq(lane_in), l31 = lane & 31, hi = lane >> 5;
    const int lgn = (gi == 0) ? 11 : (gi == 1 ? 9 : 7), n = 1 << lgn, lgd = 11 - lgn;
    for (int item = gw; item < 16 * 16 * 64; item += NGW) {
        const int qbi = item & 63, head = (item >> 6) & 15, b = item >> 10;
        const int jj0 = 32 * qbi, r = jj0 >> lgn, m0 = jj0 & (n - 1);
        const size_t jc = (size_t)b * S + (size_t)r * n;
        const bf16_t* qp = QKg + (jc + m0 + l31) * 2048 + head * 64 + 8 * hi;
        bf16x8 qf[4];
#pragma unroll
        for (int ks = 0; ks < 4; ++ks) qf[ks] = *(const bf16x8*)(qp + 16 * ks);
        f32x16 ot[2];
#pragma unroll
        for (int dt = 0; dt < 2; ++dt)
#pragma unroll
            for (int rr = 0; rr < 16; ++rr) ot[dt][rr] = 0.f;
        float mrun = -1e30f, lrun = 0.f;
#pragma unroll 1
        for (int ti = 0; ti < 5; ++ti) {
            const int kp0 = m0 - 64 + 32 * ti;
            if (kp0 < 0 || kp0 >= n) continue;
            const bf16_t* kp = QKg + (jc + kp0 + l31) * 2048 + 1024 + head * 64 + 8 * hi;
            f32x16 st;
#pragma unroll
            for (int rr = 0; rr < 16; ++rr) st[rr] = 0.f;
#pragma unroll
            for (int ks = 0; ks < 4; ++ks) { const bf16x8 kf = *(const bf16x8*)(kp + 16 * ks); st = __builtin_amdgcn_mfma_f32_32x32x16_bf16(kf, qf[ks], st, 0, 0, 0); }
            if (ti == 0) {
#pragma unroll
                for (int rr = 0; rr < 16; ++rr) if (crow(rr, hi) < l31) st[rr] = -1e30f;
            } else if (ti == 4) {
#pragma unroll
                for (int rr = 0; rr < 16; ++rr) if (crow(rr, hi) > l31) st[rr] = -1e30f;
            }
            float mx = st[0];
#pragma unroll
            for (int rr = 1; rr < 16; ++rr) mx = fmaxf(mx, st[rr]);
            mx = fmaxf(mx, __shfl_xor(mx, 32));
            const float mnew = fmaxf(mrun, mx);
            const float alpha = __builtin_amdgcn_exp2f(mrun - mnew);
            lrun *= alpha;
#pragma unroll
            for (int dt = 0; dt < 2; ++dt)
#pragma unroll
                for (int rr = 0; rr < 16; ++rr) ot[dt][rr] *= alpha;
            mrun = mnew;
            float ps = 0.f;
#pragma unroll
            for (int rr = 0; rr < 16; ++rr) { const float p = __builtin_amdgcn_exp2f(st[rr] - mrun); st[rr] = p; ps += p; }
            lrun += ps;
            bf16x8 pb[2];
#pragma unroll
            for (int s = 0; s < 2; ++s) { const int r0 = 8 * s;
                u32x4 w; w.x = pg8::cvt_pk_bf16(st[r0], st[r0 + 1]); w.y = pg8::cvt_pk_bf16(st[r0 + 2], st[r0 + 3]); w.z = pg8::cvt_pk_bf16(st[r0 + 4], st[r0 + 5]); w.w = pg8::cvt_pk_bf16(st[r0 + 6], st[r0 + 7]);
                pb[s] = __builtin_bit_cast(bf16x8, w); }
#pragma unroll
            for (int dt = 0; dt < 2; ++dt)
#pragma unroll
                for (int s = 0; s < 2; ++s) { const bf16_t* vp = Vtg + (size_t)(head * 64 + 32 * dt + l31) * M + jc + kp0 + 16 * s + 4 * hi;
                    const s16x4 lo = *(const s16x4*)vp, hi4 = *(const s16x4*)(vp + 8);
                    const bf16x8 vf = (bf16x8){lo[0], lo[1], lo[2], lo[3], hi4[0], hi4[1], hi4[2], hi4[3]};
                    ot[dt] = __builtin_amdgcn_mfma_f32_32x32x16_bf16(vf, pb[s], ot[dt], 0, 0, 0); }
        }
        const float ltot = lrun + __shfl_xor(lrun, 32);
        const float inv = 1.0f / ltot;
        float lse2 = mrun + __builtin_amdgcn_logf(ltot);
        const int tq = ((m0 + l31) << lgd) + r;
        const size_t row = (size_t)b * S + tq;
        float wa = 0.f, wg = inv;
        if (gi > 0) { const float la = LSE[row * 16 + head]; const float mxl = fmaxf(la, lse2);
            const float ea = __builtin_amdgcn_exp2f(la - mxl), eg = __builtin_amdgcn_exp2f(lse2 - mxl); const float den = 1.0f / (ea + eg);
            wa = ea * den; wg = eg * den * inv; lse2 = mxl + __builtin_amdgcn_logf(ea + eg); }
        if (gi < 2 && hi == 0) LSE[row * 16 + head] = lse2;
#pragma unroll
        for (int dt = 0; dt < 2; ++dt)
#pragma unroll
            for (int g4 = 0; g4 < 4; ++g4) { const int d0 = head * 64 + 32 * dt + 8 * g4 + 4 * hi;
                f32x4 o = (f32x4){ot[dt][4 * g4], ot[dt][4 * g4 + 1], ot[dt][4 * g4 + 2], ot[dt][4 * g4 + 3]} * wg;
                if (gi > 0) o += *(const f32x4*)(Oacc + row * D + d0) * wa;
                if (gi < 2) *(f32x4*)(Oacc + row * D + d0) = o;
                else { u32x2 w; w.x = pk2(o[0], o[1]); w.y = pk2(o[2], o[3]); *(u32x2*)(Ofin + row * D + d0) = w; } }
    }
}

__device__ __forceinline__ float sigmoidf_(float x) { return 1.0f / (1.0f + __expf(-x)); }
__device__ __forceinline__ void lru_phase(int mode, unsigned char* ldsg, const Args& a, const bf16_t* GU2, const bf16_t* Wfrag, float* AGG, bf16_t* Y, int gw, int NGW, int wave, int lane_in) {
    const int lane = opq(lane_in);
    LAS float* wl = (LAS float*)((LAS unsigned char*)ldsg + wave * 4096);
    const int tok = lane & 31, hi = lane >> 5;
    int staged_n = -1;
    float* Af = AGG; float* Hf = AGG + (size_t)NB * 64 * 1024; float* Ab = Hf + (size_t)NB * 64 * 1024; float* Hb = Ab + (size_t)NB * 64 * 1024;
    for (int item = gw; item < 16 * 16 * 64; item += NGW) {
        const int b = item >> 10, n = (item >> 6) & 15, chunk = item & 63;
        if (n != staged_n) {
            staged_n = n;
            const int ch = 64 * n + lane;
#pragma unroll
            for (int d = 0; d < 2; ++d) {
#pragma unroll
                for (int j = 0; j < 4; ++j) wl[(d * 4 + j) * 64 + lane] = a.in[I_LCW][(d * 4 + j) * 1024 + ch];
                wl[(8 + d) * 64 + lane] = a.in[I_LCB][d * 1024 + ch];
                wl[(10 + d) * 64 + lane] = a.in[I_LBA][d * 1024 + ch];
                wl[(12 + d) * 64 + lane] = a.in[I_LBX][d * 1024 + ch];
                wl[(14 + d) * 64 + lane] = -log1pf(expf(-a.in[I_LLAM][d * 1024 + ch]));
            }
            asm volatile("s_waitcnt lgkmcnt(0)" ::: "memory");
        }
        const int t = 32 * chunk + tok;
        float hsum[32];
#pragma unroll
        for (int cc = 0; cc < 32; ++cc) hsum[cc] = 0.f;
#pragma unroll 1
        for (int d = 0; d < 2; ++d) {
            float xc[32];
#pragma unroll
            for (int q = 0; q < 8; ++q) { const f32x4 bv = *(const LAS f32x4*)(wl + (8 + d) * 64 + 32 * hi + 4 * q); xc[4 * q] = bv[0]; xc[4 * q + 1] = bv[1]; xc[4 * q + 2] = bv[2]; xc[4 * q + 3] = bv[3]; }
#pragma unroll
            for (int j = 0; j < 4; ++j) {
                const int tt = (d == 0) ? (t - 3 + j) : (t + 3 - j);
                if (tt >= 0 && tt < S) {
                    const bf16_t* up = GU2 + ((size_t)b * S + tt) * 2048 + 1024 + 64 * n + 32 * hi;
#pragma unroll
                    for (int q = 0; q < 4; ++q) { const u32x4 uv = *(const u32x4*)(up + 8 * q);
                        const f32x4 w0 = *(const LAS f32x4*)(wl + (d * 4 + j) * 64 + 32 * hi + 8 * q), w1 = *(const LAS f32x4*)(wl + (d * 4 + j) * 64 + 32 * hi + 8 * q + 4);
                        xc[8 * q + 0] += w0[0] * bflo(uv.x); xc[8 * q + 1] += w0[1] * bfhi(uv.x); xc[8 * q + 2] += w0[2] * bflo(uv.y); xc[8 * q + 3] += w0[3] * bfhi(uv.y);
                        xc[8 * q + 4] += w1[0] * bflo(uv.z); xc[8 * q + 5] += w1[1] * bfhi(uv.z); xc[8 * q + 6] += w1[2] * bflo(uv.w); xc[8 * q + 7] += w1[3] * bfhi(uv.w); }
                }
            }
            bf16x8 bx[4];
#pragma unroll
            for (int ks = 0; ks < 4; ++ks) { u32x4 w; w.x = pk2(xc[8 * ks], xc[8 * ks + 1]); w.y = pk2(xc[8 * ks + 2], xc[8 * ks + 3]); w.z = pk2(xc[8 * ks + 4], xc[8 * ks + 5]); w.w = pk2(xc[8 * ks + 6], xc[8 * ks + 7]); bx[ks] = __builtin_bit_cast(bf16x8, w); }
            float cyv = 0.f;
            if (mode == 1) {
                if (d == 0) { for (int k = 0; k < chunk; ++k) { const size_t o = ((size_t)b * 64 + k) * 1024 + 64 * n + lane; cyv = Af[o] * cyv + Hf[o]; } }
                else { for (int k = 63; k > chunk; --k) { const size_t o = ((size_t)b * 64 + k) * 1024 + 64 * n + lane; cyv = Ab[o] * cyv + Hb[o]; } }
            }
#pragma unroll
            for (int jt = 0; jt < 2; ++jt) {
                f32x16 pre[2];
#pragma unroll
                for (int gt = 0; gt < 2; ++gt) {
#pragma unroll
                    for (int rr = 0; rr < 16; ++rr) pre[gt][rr] = 0.f;
#pragma unroll
                    for (int ks = 0; ks < 4; ++ks) { const bf16x8 wf = *(const bf16x8*)(Wfrag + ((size_t)((((d * 16 + n) * 2 + gt) * 2 + jt) * 4 + ks) * 64 + lane) * 8);
                        pre[gt] = __builtin_amdgcn_mfma_f32_32x32x16_bf16(wf, bx[ks], pre[gt], 0, 0, 0); }
                }
                float av[16], bv[16];
#pragma unroll
                for (int rr = 0; rr < 16; ++rr) { const int cc = 16 * jt + rr; const int ch = 32 * hi + cc;
                    const float ra = sigmoidf_(pre[0][rr] + wl[(10 + d) * 64 + ch]), ix = sigmoidf_(pre[1][rr] + wl[(12 + d) * 64 + ch]);
                    const float la = 8.0f * ra * wl[(14 + d) * 64 + ch];
                    av[rr] = __expf(la); bv[rr] = sqrtf(fmaxf(1.0f - __expf(2.0f * la), 0.f)) * ix * xc[cc]; }
#pragma unroll
                for (int off = 1; off < 32; off <<= 1) {
                    const bool act = (d == 0) ? (tok >= off) : (tok + off < 32);
                    const int src = (d == 0) ? (lane - off) : (lane + off);
#pragma unroll
                    for (int rr = 0; rr < 16; ++rr) { const float ap = __shfl(av[rr], src), bp = __shfl(bv[rr], src);
                        if (act) { bv[rr] = av[rr] * bp + bv[rr]; av[rr] = av[rr] * ap; } }
                }
                if (mode == 0) {
                    const bool w = (d == 0) ? (tok == 31) : (tok == 0);
                    if (w) { float* pa = (d == 0 ? Af : Ab) + ((size_t)b * 64 + chunk) * 1024 + 64 * n + 32 * hi + 16 * jt; float* ph = (d == 0 ? Hf : Hb) + ((size_t)b * 64 + chunk) * 1024 + 64 * n + 32 * hi + 16 * jt;
#pragma unroll
                        for (int q = 0; q < 4; ++q) { *(f32x4*)(pa + 4 * q) = (f32x4){av[4 * q], av[4 * q + 1], av[4 * q + 2], av[4 * q + 3]}; *(f32x4*)(ph + 4 * q) = (f32x4){bv[4 * q], bv[4 * q + 1], bv[4 * q + 2], bv[4 * q + 3]}; } }
                } else {
#pragma unroll
                    for (int rr = 0; rr < 16; ++rr) { const float cv = __shfl(cyv, 32 * hi + 16 * jt + rr); hsum[16 * jt + rr] += bv[rr] + av[rr] * cv; }
                }
            }
        }
        if (mode == 1) {
            const size_t row = (size_t)b * S + t;
            const bf16_t* gp = GU2 + row * 2048 + 64 * n + 32 * hi;
            bf16_t* yp = Y + row * D + 64 * n + 32 * hi;
#pragma unroll
            for (int q = 0; q < 4; ++q) { const u32x4 gv = *(const u32x4*)(gp + 8 * q);
                float gx[8] = {bflo(gv.x), bfhi(gv.x), bflo(gv.y), bfhi(gv.y), bflo(gv.z), bfhi(gv.z), bflo(gv.w), bfhi(gv.w)};
                float yv[8];
#pragma unroll
                for (int e = 0; e < 8; ++e) { const float x = gx[e]; const float z = 0.7978845608028654f * (x + 0.044715f * x * x * x); yv[e] = (x / (1.0f + __expf(-2.0f * z))) * hsum[8 * q + e]; }
                u32x4 w; w.x = pk2(yv[0], yv[1]); w.y = pk2(yv[2], yv[3]); w.z = pk2(yv[4], yv[5]); w.w = pk2(yv[6], yv[7]);
                *(u32x4*)(yp + 8 * q) = w; }
        }
    }
}

#ifndef GMASK
#define GMASK 0xffff
#endif
#define GSITE(n, stmt) do { if constexpr ((GMASK >> (n)) & 1) { stmt; } } while (0)
__global__ void __launch_bounds__(NT, 2) fwd(Args a) {
    extern __shared__ __attribute__((aligned(16))) unsigned char lds[];
    cg::grid_group grid = cg::this_grid();
    const int tid = threadIdx.x, lane = tid & 63, wave = __builtin_amdgcn_readfirstlane(tid >> 6);
    const int gw = blockIdx.x * 8 + wave, NGW = gridDim.x * 8;
    LAS unsigned char* ldsl = (LAS unsigned char*)lds;
    LAS float* scr = (LAS float*)(ldsl + wave * 16384);
    unsigned char* ws = a.ws;
    bf16_t* XN = (bf16_t*)(ws + WS_XN);
    float* cosT = (float*)(ws + T_COS); float* sinT = (float*)(ws + T_SIN); float* rstd0 = (float*)(ws + T_RSTD);
    float* H = a.out;

    {
        for (int g = 0; g < 4; ++g) transpose_mat(a.in[I_POOLW] + (size_t)g * 65536, 256, 256, 256, 0, (bf16_t*)(ws + W_POOL) + (size_t)g * 65536, 0, scr, gw, NGW, lane);
        transpose_mat(a.in[I_DQKV], D, 2048, 3072, 0, (bf16_t*)(ws + W_DQK), 1, scr, gw, NGW, lane);
        transpose_mat(a.in[I_DQKV], D, 1024, 3072, 2048, (bf16_t*)(ws + W_DV), 0, scr, gw, NGW, lane);
        transpose_mat(a.in[I_DWO], D, D, D, 0, (bf16_t*)(ws + W_DO), 0, scr, gw, NGW, lane);
        transpose_mat(a.in[I_LWIN], D, 2048, 2048, 0, (bf16_t*)(ws + W_LIN), 0, scr, gw, NGW, lane);
        transpose_mat(a.in[I_LWOUT], D, D, D, 0, (bf16_t*)(ws + W_LOUT), 0, scr, gw, NGW, lane);
        transpose_mat(a.in[I_XQKV], D, 9216, 9216, 0, (bf16_t*)(ws + W_XQKV), 2, scr, gw, NGW, lane);
        transpose_mat(a.in[I_XWO], D, D, D, 0, (bf16_t*)(ws + W_XO), 0, scr, gw, NGW, lane);
        convert_ffn(a, 0, scr, gw, NGW, lane);
        for (int e = blockIdx.x * NT + tid; e < 2 * 16 * 2 * 2 * 4 * 64; e += gridDim.x * NT) {
            const int ln = e & 63, ks = (e >> 6) & 3, jt = (e >> 8) & 1, gt = (e >> 9) & 1, n = (e >> 10) & 15, d = e >> 14;
            const int rho = (ln & 31) + 32 * jt, hi = ln >> 5;
            const int jout = 32 * ((rho >> 2) & 1) + 4 * (rho >> 3) + (rho & 3);
            const float* Wg = (gt == 0 ? a.in[I_LWA] : a.in[I_LWX]) + (size_t)(d * 16 + n) * 4096;
            u32x4 w; float v[8];
#pragma unroll
            for (int j8 = 0; j8 < 8; ++j8) v[j8] = Wg[(32 * hi + 8 * ks + j8) * 64 + jout];
            w.x = pk2(v[0], v[1]); w.y = pk2(v[2], v[3]); w.z = pk2(v[4], v[5]); w.w = pk2(v[6], v[7]);
            *(u32x4*)((bf16_t*)(ws + W_LG) + (size_t)e * 8) = w;
        }
        for (int e = blockIdx.x * NT + tid; e < S * 32; e += gridDim.x * NT) {
            const int t = e >> 5, i = e & 31;
            const float inv = exp2f(-(float)i * (13.287712379549449f / 32.0f));
            const float ang = (float)((const int*)a.in[I_POS])[t] * inv;
            cosT[e] = cosf(ang); sinT[e] = sinf(ang);
        }
        for (int m = gw; m < M; m += NGW) {
            const f32x4* xr = (const f32x4*)(a.in[I_X] + (size_t)m * D) + lane; float s = 0.f;
#pragma unroll
            for (int j = 0; j < 4; ++j) { const f32x4 v = xr[64 * j]; s += (v.x * v.x + v.y * v.y) + (v.z * v.z + v.w * v.w); }
            s = wave_sum(s);
            if (lane == 0) rstd0[m] = 1.0f / sqrtf(s * (1.f / D) + 1e-6f);
        }
    }
    grid.sync();

    for (int layer = 0; layer < 4; ++layer) {
        if (layer == 0) {
            const float* x = a.in[I_X]; const float* gain = a.in[I_MIXNORM]; const int lane = opq(tid & 63);
            for (int m = gw; m < M; m += NGW) {
                const int t = m & (S - 1); const size_t rb = (size_t)(m - t);
#pragma unroll
                for (int g = 0; g < 4; ++g) {
                    const int half = 1 << g; const int lo = max(t - half, 0), hi = min(t + half, S);
                    f32x4 sum = (f32x4){0.f, 0.f, 0.f, 0.f};
                    for (int tt = lo; tt < hi; ++tt) sum += *((const f32x4*)(x + (rb + tt) * D + 256 * g) + lane) * rstd0[rb + tt];
                    const f32x4 ctr = *((const f32x4*)(x + (size_t)m * D + 256 * g) + lane) * rstd0[m];
                    const f32x4 gv = *((const f32x4*)(gain + 256 * g) + lane);
                    const f32x4 p = (sum * (1.0f / (float)(hi - lo)) - ctr) * gv;
                    u32x2 w; w.x = pk2(p[0], p[1]); w.y = pk2(p[2], p[3]);
                    *((u32x2*)(XN + (size_t)m * D + 256 * g) + lane) = w;
                }
            }
            grid.sync();
        } else {
            convert_ffn(a, layer, scr, gw, NGW, lane);
            norm_rows(H, a.in[I_MIXNORM] + layer * D, XN, gw, NGW, lane);
            grid.sync();
            if (layer == 1) {
                bf16_t* QK = (bf16_t*)(ws + WS_SCR); bf16_t* Vt = (bf16_t*)(ws + WS_SCR + 128 * MiB);
                { pg8::Gemm g{XN, (const bf16_t*)(ws + W_DQK), D, D, D, 0, 0, 128, 8}; pg8::EpiRope E{QK, cosT, sinT, 0, QSCALE}; GSITE(1, pg8::gemm_phase(ldsl, g, E)); }
                { pg8::Gemm g{(const bf16_t*)(ws + W_DV), XN, D, D, D, 0, 0, 4, 128}; pg8::EpiPlain E{Vt, (size_t)M}; GSITE(2, pg8::gemm_phase(ldsl, g, E)); }
                grid.sync();
                float s1 = 0.f, s2 = 0.f;
                for (int i = 0; i < 64; ++i) { s1 += a.in[I_LQ1][i] * a.in[I_LK1][i]; s2 += a.in[I_LQ2][i] * a.in[I_LK2][i]; }
                const float lam_init = 0.8f - 0.6f * expf(-0.3f * 1.0f);
                const float lam = expf(s1) - expf(s2) + lam_init;
#ifndef NO_DIFF
                diff_attn_phase(lds, QK, Vt, XN, lam, lam_init, a.in[I_SUBLN]);
#endif
                grid.sync();
            } else if (layer == 2) {
                bf16_t* GU2 = (bf16_t*)(ws + WS_SCR);
                { pg8::Gemm g{XN, (const bf16_t*)(ws + W_LIN), D, D, D, 0, 0, 128, 8}; pg8::EpiPlain E{GU2, 2048}; GSITE(3, pg8::gemm_phase(ldsl, g, E)); }
                grid.sync();
#ifndef NO_LRU
                lru_phase(0, lds, a, GU2, (const bf16_t*)(ws + W_LG), (float*)(ws + T_AGG), XN, gw, NGW, wave, lane);
#endif
                grid.sync();
#ifndef NO_LRU
                lru_phase(1, lds, a, GU2, (const bf16_t*)(ws + W_LG), (float*)(ws + T_AGG), XN, gw, NGW, wave, lane);
#endif
                grid.sync();
            } else {
                bf16_t* QKg = (bf16_t*)(ws + WS_SCR); bf16_t* Vtg = (bf16_t*)(ws + WS_SCR + 128 * MiB); float* Oacc = (float*)(ws + WS_SCR + 192 * MiB); float* LSE = (float*)(ws + T_LSE);
                for (int gi = 0; gi < 3; ++gi) {
                    const bf16_t* Wg = (const bf16_t*)(ws + W_XQKV) + (size_t)gi * 3072 * D;
                    { pg8::Gemm g{XN, Wg, D, D, D, gi, 0, 128, 8}; pg8::EpiRope E{QKg, cosT, sinT, gi, QSCALE}; GSITE(4, pg8::gemm_phase(ldsl, g, E)); }
                    { pg8::Gemm g{Wg + (size_t)2048 * D, XN, D, D, D, 0, gi, 4, 128}; pg8::EpiPlain E{Vtg, (size_t)M}; GSITE(5, pg8::gemm_phase(ldsl, g, E)); }
                    grid.sync();
#ifndef NO_DIL
                    dil_attn_phase(gi, QKg, Vtg, Oacc, LSE, XN, gw, NGW, lane);
#endif
                    grid.sync();
                }
            }
        }
        {
            pg8::Gemm g{XN, (const bf16_t*)(ws + (layer == 0 ? W_POOL : layer == 1 ? W_DO : layer == 2 ? W_LOUT : W_XO)), layer == 0 ? 256 : D, D, layer == 0 ? 256 : D, layer == 0 ? 3 : 0, 0, 128, 4};
            pg8::EpiResid E{layer == 0 ? a.in[I_X] : H, H, layer == 0 ? a.in[I_POOLS] : nullptr};
            GSITE(6, pg8::gemm_phase(ldsl, g, E));
        }
        grid.sync();
        norm_rows(H, a.in[I_FNORM] + layer * D, XN, gw, NGW, lane);
        grid.sync();
        bf16_t* GU = (bf16_t*)(ws + WS_SCR);
        { pg8::Gemm g{XN, (const bf16_t*)(ws + W_UP), D, D, D, 0, 0, 128, 22}; pg8::EpiPlain E{GU, (size_t)(2 * DFF)}; GSITE(7, pg8::gemm_phase(ldsl, g, E)); }
        grid.sync();
        {
            const float* cw = a.in[I_FCW] + (size_t)layer * 3 * DFF; const float* cb = a.in[I_FCB] + (size_t)layer * DFF; const int lane = opq(tid & 63);
            for (int m = gw; m < M; m += NGW) {
                const int t = m & (S - 1); const bool hp = t > 0, hn = t < S - 1;
                bf16_t* rowp = GU + (size_t)m * (2 * DFF);
                for (int idx = lane; idx < DFF / 8; idx += 64) {
                    const int c0 = 8 * idx;
                    const u32x4 gc = *(const u32x4*)(rowp + c0);
                    const u32x4 gp = hp ? *(const u32x4*)(rowp - 2 * DFF + c0) : (u32x4){0u, 0u, 0u, 0u};
                    const u32x4 gn = hn ? *(const u32x4*)(rowp + 2 * DFF + c0) : (u32x4){0u, 0u, 0u, 0u};
                    const u32x4 uu = *(const u32x4*)(rowp + DFF + c0);
                    float o[8];
#pragma unroll
                    for (int h2 = 0; h2 < 2; ++h2) {
                        const f32x4 w0 = *(const f32x4*)(cw + c0 + 4 * h2), w1 = *(const f32x4*)(cw + DFF + c0 + 4 * h2), w2 = *(const f32x4*)(cw + 2 * DFF + c0 + 4 * h2), bb = *(const f32x4*)(cb + c0 + 4 * h2);
                        const unsigned p0 = h2 ? gp.z : gp.x, p1 = h2 ? gp.w : gp.y, q0 = h2 ? gc.z : gc.x, q1 = h2 ? gc.w : gc.y, n0 = h2 ? gn.z : gn.x, n1 = h2 ? gn.w : gn.y, u0 = h2 ? uu.z : uu.x, u1 = h2 ? uu.w : uu.y;
                        f32x2 v0, v1;
                        v0.x = bb[0] + w0[0] * bflo(p0) + w1[0] * bflo(q0) + w2[0] * bflo(n0);
                        v0.y = bb[1] + w0[1] * bfhi(p0) + w1[1] * bfhi(q0) + w2[1] * bfhi(n0);
                        v1.x = bb[2] + w0[2] * bflo(p1) + w1[2] * bflo(q1) + w2[2] * bflo(n1);
                        v1.y = bb[3] + w0[3] * bfhi(p1) + w1[3] * bfhi(q1) + w2[3] * bfhi(n1);
                        const f32x2 a0 = gelu_pk(v0), a1 = gelu_pk(v1);
                        o[4 * h2 + 0] = a0.x * bflo(u0); o[4 * h2 + 1] = a0.y * bfhi(u0);
                        o[4 * h2 + 2] = a1.x * bflo(u1); o[4 * h2 + 3] = a1.y * bfhi(u1);
                    }
                    u32x4 w; w.x = pk2(o[0], o[1]); w.y = pk2(o[2], o[3]); w.z = pk2(o[4], o[5]); w.w = pk2(o[6], o[7]);
                    *(u32x4*)(rowp + DFF + c0) = w;
                }
            }
        }
        grid.sync();
        { pg8::Gemm g{GU + DFF, (const bf16_t*)(ws + W_DOWN), DFF, 2 * DFF, DFF, 0, 0, 128, 4}; pg8::EpiResid E{H, H, nullptr}; GSITE(8, pg8::gemm_phase(ldsl, g, E)); }
        grid.sync();
    }
    {
        const int lane = opq(tid & 63);
        f32x4 gv[4];
#pragma unroll
        for (int j = 0; j < 4; ++j) gv[j] = ((const f32x4*)a.in[I_FINAL])[lane + 64 * j];
        for (int m = gw; m < M; m += NGW) {
            f32x4* xr = (f32x4*)(H + (size_t)m * D) + lane;
            f32x4 v[4]; float s = 0.f;
#pragma unroll
            for (int j = 0; j < 4; ++j) { v[j] = xr[64 * j]; s += (v[j].x * v[j].x + v[j].y * v[j].y) + (v[j].z * v[j].z + v[j].w * v[j].w); }
            const float r = 1.0f / sqrtf(wave_sum(s) * (1.f / D) + 1e-6f);
#pragma unroll
            for (int j = 0; j < 4; ++j) xr[64 * j] = v[j] * r * gv[j];
        }
    }
}

extern "C" void kernel_launch(void* const* d_in, const int* in_sizes, int n_in, void* d_out, int out_size, void* d_ws, size_t ws_size, hipStream_t stream) {
    static int grid = 0;
    if (grid == 0) {
        if (n_in != 29 || in_sizes[0] != M * D || out_size != M * D || ws_size < WS_END) { fprintf(stderr, "kernel_launch: unexpected shapes (n_in %d, ws %zu)\n", n_in, ws_size); grid = -1; return; }
        int dev = 0, cus = 0, per_cu = 0;
        (void)hipGetDevice(&dev);
        (void)hipDeviceGetAttribute(&cus, hipDeviceAttributeMultiprocessorCount, dev);
        (void)hipFuncSetAttribute((const void*)fwd, hipFuncAttributeMaxDynamicSharedMemorySize, LDS_BYTES);
        (void)hipOccupancyMaxActiveBlocksPerMultiprocessor(&per_cu, (const void*)fwd, NT, LDS_BYTES);
        if (per_cu < 1) per_cu = 1;
        grid = cus;
        (void)hipGetLastError();
    }
    if (grid < 0) return;
    Args a{};
    for (int i = 0; i < 29; ++i) a.in[i] = (const float*)d_in[i];
    a.out = (float*)d_out; a.ws = (unsigned char*)d_ws;
    void* args[] = {&a};
    hipError_t e = hipLaunchCooperativeKernel((void*)fwd, dim3(grid), dim3(NT), args, LDS_BYTES, stream);
    if (e != hipSuccess) fprintf(stderr, "cooperative launch failed: %s\n", hipGetErrorString(e));
}
```

```cpp
#include <hip/hip_runtime.h>
#include <hip/hip_cooperative_groups.h>
#include <cstdio>
#include <cstdint>
namespace cg = cooperative_groups;

#define LAS __attribute__((address_space(3)))
typedef unsigned short bf16_t;
typedef short bf16x8 __attribute__((ext_vector_type(8)));
typedef short s16x4 __attribute__((ext_vector_type(4)));
typedef float f32x4 __attribute__((ext_vector_type(4)));
typedef float f32x2 __attribute__((ext_vector_type(2)));
typedef float f32x16 __attribute__((ext_vector_type(16)));
typedef unsigned u32x4 __attribute__((ext_vector_type(4)));
typedef unsigned u32x2 __attribute__((ext_vector_type(2)));

constexpr int NT = 512;
constexpr int LDS_BYTES = 147456;
constexpr int M = 32768, D = 1024, S = 2048, NB = 16, DFF = 2816;
constexpr float QSCALE = 0.125f * 1.4426950408889634f;

__device__ __forceinline__ unsigned f2bf(float f) { unsigned u = __builtin_bit_cast(unsigned, f); return (u + 0x7fffu + ((u >> 16) & 1u)) >> 16; }
typedef __bf16 bf16x2_t __attribute__((ext_vector_type(2)));
__device__ __forceinline__ unsigned pk2(float lo, float hi) { const f32x2 v = (f32x2){lo, hi}; const bf16x2_t b = __builtin_convertvector(v, bf16x2_t); return __builtin_bit_cast(unsigned, b); }
__device__ __forceinline__ float bf2f(unsigned short h) { return __builtin_bit_cast(float, (unsigned)h << 16); }
__device__ __forceinline__ float bflo(unsigned w) { return __builtin_bit_cast(float, w << 16); }
__device__ __forceinline__ float bfhi(unsigned w) { return __builtin_bit_cast(float, w & 0xffff0000u); }
__device__ __forceinline__ float wave_sum(float v) {
#pragma unroll
    for (int o = 1; o < 64; o <<= 1) v += __shfl_xor(v, o);
    return v;
}
__device__ __forceinline__ int opq(int v) { asm volatile("" : "+v"(v)); return v; }
__device__ __forceinline__ int lane_id() { int r; asm volatile("v_mbcnt_lo_u32_b32 %0, -1, 0\n\tv_mbcnt_hi_u32_b32 %0, -1, %0" : "=v"(r)); return r; }
__device__ __forceinline__ float swapmax(float v) { unsigned a = __builtin_bit_cast(unsigned, v), b = a; asm volatile("" : "+v"(b));
    const auto rr = __builtin_amdgcn_permlane32_swap(a, b, false, false);
    float r; asm volatile("v_max_f32_e32 %0, %1, %2" : "=v"(r) : "v"(rr[0]), "v"(rr[1])); return r; }
__device__ __forceinline__ float swapsum(float v) { unsigned a = __builtin_bit_cast(unsigned, v), b = a; asm volatile("" : "+v"(b));
    const auto rr = __builtin_amdgcn_permlane32_swap(a, b, false, false);
    float r; asm volatile("v_add_f32_e32 %0, %1, %2" : "=v"(r) : "v"(rr[0]), "v"(rr[1])); return r; }
__device__ __forceinline__ int crow(int r, int hi) { return (r & 3) + 8 * (r >> 2) + 4 * hi; }
__device__ __forceinline__ f32x2 gelu_pk(f32x2 v) {
    const f32x2 av = __builtin_elementwise_abs(v), d = av * 0.2316418882f + 1.0f;
    f32x2 t; t.x = __builtin_amdgcn_rcpf(d.x); t.y = __builtin_amdgcn_rcpf(d.y);
    f32x2 q = t * 0.5307027145f + (-0.7265760135f); q = q * t + 0.7107068705f; q = q * t + (-0.142248368f); q = q * t + 0.127414796f; q = q * t;
    const f32x2 s = (v * v) * (-0.72134752044f);
    f32x2 e; e.x = __builtin_amdgcn_exp2f(s.x); e.y = __builtin_amdgcn_exp2f(s.y);
    const f32x2 m = v * (q * e), r = v - m;
    f32x2 o; o.x = v.x < 0.f ? m.x : r.x; o.y = v.y < 0.f ? m.y : r.y; return o;
}

constexpr size_t MiB = 1u << 20;
constexpr size_t W_POOL = 0, W_DQK = 1 * MiB, W_DV = 5 * MiB, W_DO = 7 * MiB, W_LIN = 9 * MiB, W_LG = 13 * MiB, W_LOUT = 14 * MiB, W_XQKV = 16 * MiB, W_XO = 34 * MiB,
                 W_UP = 36 * MiB, W_DOWN = 47 * MiB, T_COS = 53 * MiB, T_SIN = 53 * MiB + 256 * 1024, T_RSTD = 53 * MiB + 512 * 1024, T_RSS = 54 * MiB, T_LSE = 56 * MiB, T_CTL = 58 * MiB,
                 WS_XN = 59 * MiB, WS_SCR = 123 * MiB, WS_MO = WS_SCR + 320 * MiB, T_AGG = WS_SCR + 128 * MiB, WS_END = 512 * MiB;
static_assert(WS_MO + 64 * MiB <= WS_END, "workspace map");

namespace pg8 {
constexpr int BM = 256, BK = 64, HALF = 128, HTB = HALF * BK * 2, STAGE_BYTES = 8 * HTB, NXCD = 8, WGM = 8;
__device__ __forceinline__ int lds_byte(int r, int c) { const int st = (r >> 4) * 2 + (c >> 5), rr = r & 15, cc = c & 31, ob = rr * 64 + cc * 2; return st * 1024 + (ob ^ (((ob >> 9) & 1) << 5)); }
__device__ __forceinline__ void stage_rc(int b, int& R, int& C) { const int st = b / 1024, sb = b % 1024, swz = sb ^ (((sb >> 9) & 1) << 5); R = (st >> 1) * 16 + swz / 64; C = (st & 1) * 32 + (swz % 64) / 2; }
__device__ __forceinline__ int perm32(int rho) { const int n = rho >> 4, i = rho & 15; return 8 * (i >> 2) + 4 * n + (i & 3); }

struct Unit { int pm, pn; };
struct Gemm { const bf16_t* A; const bf16_t* Bt; int K; int lda, ldb; int amode, bmode; int nM, nN; };
__device__ __forceinline__ size_t map_base(int mode, int p, int other, int ld) {
    if (mode == 1) { const int b = p >> 3, q = p & 7, r = q >> 1, mu = q & 1; return (size_t)(b * 2048 + 1024 * mu + r) * ld; }
    if (mode == 2) { const int b = p >> 3, rho = p & 7; return (size_t)(b * 2048 + 2 * rho) * ld; }
    if (mode == 3) return (size_t)p * 256 * ld + (size_t)other * 256;
    return (size_t)p * 256 * ld;
}
__device__ __forceinline__ int map_rs(int mode, int ld) { return mode == 1 ? 4 * ld : (mode == 2 ? 16 * ld : ld); }
__device__ __forceinline__ int map_hs(int mode, int ld) { return mode == 1 ? 512 * ld : (mode == 2 ? ld : 128 * ld); }

struct StaticOrder {
    int nM, nN, nwg, G, c;
    __device__ __forceinline__ void init(int nM_, int nN_, int G_, int c_) { nM = nM_; nN = nN_; nwg = nM * nN; G = G_; c = c_; }
    __device__ __forceinline__ bool next(int i, Unit& u) const {
        const long L = (long)i * G + c; if (L >= nwg) return false;
        int wgid = (int)L; { const int q = nwg / NXCD, r = nwg % NXCD, xcd = wgid % NXCD, off = wgid / NXCD; wgid = (xcd < r ? xcd * (q + 1) : r * (q + 1) + (xcd - r) * q) + off; }
        const int nig = WGM * nN, gid = wgid / nig, fm = gid * WGM, gsz = (nM - fm) < WGM ? (nM - fm) : WGM;
        u.pm = fm + ((wgid % nig) % gsz); u.pn = (wgid % nig) / gsz; return true;
    }
};

__device__ __forceinline__ unsigned cvt_pk_bf16(float lo, float hi) { unsigned r; asm volatile("v_cvt_pk_bf16_f32 %0, %1, %2" : "=v"(r) : "v"(lo), "v"(hi)); return r; }

__device__ __forceinline__ float rstd_of(const float* RSS, size_t row) {
    const f32x4 a = *(const f32x4*)(RSS + row * 4);
    return __builtin_amdgcn_rsqf(((a[0] + a[1]) + (a[2] + a[3])) * (1.0f / 1024.0f) + 1e-6f);
}
struct EpiPlain {
    static constexpr bool PERM = true;
    unsigned char* ws; size_t ooff; size_t ldc; int smode; int tmap;
    __device__ __forceinline__ void operator()(const f32x4 (&acc)[2][2][4][2], const Unit& u, int wr, int wc, int fr, int fq) const {
        const int row0 = u.pm * BM + wr * 64 + fr, col0 = u.pn * BM + wc * 32 + 8 * fq;
        bf16_t* O = (bf16_t*)(ws + ooff); const float* RSS = (const float*)(ws + T_RSS);
        float rsv[2][4];
#pragma unroll
        for (int ai = 0; ai < 2; ++ai)
#pragma unroll
            for (int m = 0; m < 4; ++m) rsv[ai][m] = (smode == 1) ? rstd_of(RSS, (size_t)(row0 + ai * HALF + m * 16)) : 1.f;
        f32x4 cs[2][2];
#pragma unroll
        for (int bj = 0; bj < 2; ++bj)
#pragma unroll
            for (int n = 0; n < 2; ++n)
#pragma unroll
                for (int e = 0; e < 4; ++e) { float v = 1.f;
                    if (smode == 2) { const int j = col0 + bj * HALF + 4 * n + e; const int jj = j & 2047; int t = jj; if (tmap == 1) t = 4 * (jj & 511) + (jj >> 9); else if (tmap == 2) t = 16 * (jj & 127) + (jj >> 7);
                        v = rstd_of(RSS, (size_t)(j - jj + t)); }
                    cs[bj][n][e] = v; }
#pragma unroll
        for (int ai = 0; ai < 2; ++ai)
#pragma unroll
            for (int m = 0; m < 4; ++m) { const int row = row0 + ai * HALF + m * 16; bf16_t* rowp = O + (size_t)row * ldc + col0;
                const float rs = rsv[ai][m];
#pragma unroll
                for (int bj = 0; bj < 2; ++bj) { const f32x4 v0 = acc[ai][bj][m][0] * cs[bj][0] * rs, v1 = acc[ai][bj][m][1] * cs[bj][1] * rs;
                    u32x4 w; w.x = cvt_pk_bf16(v0[0], v0[1]); w.y = cvt_pk_bf16(v0[2], v0[3]); w.z = cvt_pk_bf16(v1[0], v1[1]); w.w = cvt_pk_bf16(v1[2], v1[3]);
                    *(u32x4*)(rowp + bj * HALF) = w; } }
    }
};
struct EpiResid {
    static constexpr bool PERM = true;
    const float* xres; const float* cs; unsigned char* ws; LAS float* part;
    __device__ __forceinline__ void operator()(const f32x4 (&acc)[2][2][4][2], const Unit& u, int wr, int wc, int fr, int fq) const {
        const int col0 = u.pn * BM + wc * 32 + 8 * fq;
        bf16_t* XH = (bf16_t*)(ws + WS_XN); float* RSS = (float*)(ws + T_RSS);
        f32x4 sv[2][2];
#pragma unroll
        for (int bj = 0; bj < 2; ++bj)
#pragma unroll
            for (int n = 0; n < 2; ++n) sv[bj][n] = cs ? *(const f32x4*)(cs + col0 + bj * HALF + n * 4) : (f32x4){1.f, 1.f, 1.f, 1.f};
#pragma unroll
        for (int ai = 0; ai < 2; ++ai)
#pragma unroll
            for (int m = 0; m < 4; ++m) { const int row = u.pm * BM + ai * HALF + wr * 64 + m * 16 + fr; const size_t off = (size_t)row * D + col0; float ss = 0.f;
#pragma unroll
                for (int bj = 0; bj < 2; ++bj) {
                    f32x4 r0, r1;
                    if (xres) { r0 = *(const f32x4*)(xres + off + bj * HALF); r1 = *(const f32x4*)(xres + off + bj * HALF + 4); }
                    else { const u32x4 rv = *(const u32x4*)(XH + off + bj * HALF); r0 = (f32x4){bflo(rv.x), bfhi(rv.x), bflo(rv.y), bfhi(rv.y)}; r1 = (f32x4){bflo(rv.z), bfhi(rv.z), bflo(rv.w), bfhi(rv.w)}; }
                    const f32x4 o0 = r0 + acc[ai][bj][m][0] * sv[bj][0], o1 = r1 + acc[ai][bj][m][1] * sv[bj][1];
                    u32x4 w; w.x = cvt_pk_bf16(o0[0], o0[1]); w.y = cvt_pk_bf16(o0[2], o0[3]); w.z = cvt_pk_bf16(o1[0], o1[1]); w.w = cvt_pk_bf16(o1[2], o1[3]);
                    *(u32x4*)(XH + off + bj * HALF) = w;
                    ss += ((o0[0] * o0[0] + o0[1] * o0[1]) + (o0[2] * o0[2] + o0[3] * o0[3])) + ((o1[0] * o1[0] + o1[1] * o1[1]) + (o1[2] * o1[2] + o1[3] * o1[3])); }
                ss += __shfl_xor(ss, 16); ss += __shfl_xor(ss, 32);
                if (fq == 0) part[wc * 256 + ai * HALF + wr * 64 + m * 16 + fr] = ss; }
        asm volatile("s_waitcnt lgkmcnt(0)" ::: "memory"); __builtin_amdgcn_s_barrier(); asm volatile("" ::: "memory");
        const int tl = (wr * 4 + wc) * 64 + fq * 16 + fr;
        if (tl < 256) RSS[(size_t)(u.pm * BM + tl) * 4 + u.pn] = (part[tl] + part[256 + tl]) + (part[512 + tl] + part[768 + tl]);
    }
};
struct EpiRope {
    static constexpr bool PERM = true;
    unsigned char* ws; int mode; float qscale;
    __device__ __forceinline__ void operator()(const f32x4 (&acc)[2][2][4][2], const Unit& u, int wr, int wc, int fr, int fq) const {
        const int colt = u.pn * BM; const float sc = (colt < 1024) ? qscale : 1.f;
        bf16_t* O = (bf16_t*)(ws + WS_SCR); const float* cosT = (const float*)(ws + T_COS); const float* sinT = (const float*)(ws + T_SIN); const float* RSS = (const float*)(ws + T_RSS);
        float rsv[2][4];
#pragma unroll
        for (int ai = 0; ai < 2; ++ai)
#pragma unroll
            for (int m = 0; m < 4; ++m) { const int row = u.pm * BM + ai * HALF + wr * 64 + m * 16 + fr; const int jj = row & 2047;
                int t = jj; if (mode == 1) t = 4 * (jj & 511) + (jj >> 9); else if (mode == 2) t = 16 * (jj & 127) + (jj >> 7);
                rsv[ai][m] = rstd_of(RSS, (size_t)(row - jj + t)); }
#pragma unroll
        for (int ai = 0; ai < 2; ++ai)
#pragma unroll
            for (int m = 0; m < 4; ++m) { const int row = u.pm * BM + ai * HALF + wr * 64 + m * 16 + fr; const int jj = row & 2047;
                int t = jj; if (mode == 1) t = 4 * (jj & 511) + (jj >> 9); else if (mode == 2) t = 16 * (jj & 127) + (jj >> 7);
                const float scr_ = sc * rsv[ai][m];
#pragma unroll
                for (int bj = 0; bj < 2; ++bj) { const int col8 = colt + bj * HALF + wc * 32 + 8 * fq; const int hb = col8 & ~63, i4 = ((col8 & 63) >> 3) * 4;
                    const f32x4 c4 = *(const f32x4*)(cosT + t * 32 + i4), s4 = *(const f32x4*)(sinT + t * 32 + i4);
                    const f32x4 x1 = acc[ai][bj][m][0], x2 = acc[ai][bj][m][1];
                    const f32x4 o1 = (x1 * c4 - x2 * s4) * scr_, o2 = (x2 * c4 + x1 * s4) * scr_;
                    u32x2 w1, w2; w1.x = cvt_pk_bf16(o1[0], o1[1]); w1.y = cvt_pk_bf16(o1[2], o1[3]); w2.x = cvt_pk_bf16(o2[0], o2[1]); w2.y = cvt_pk_bf16(o2[2], o2[3]);
                    bf16_t* p = O + (size_t)row * 2048 + hb + i4;
                    *(u32x2*)p = w1; *(u32x2*)(p + 32) = w2; } }
    }
};


__device__ __forceinline__ float dpp_ror1(float v)  { return __builtin_bit_cast(float, __builtin_amdgcn_update_dpp(0, __builtin_bit_cast(int, v), 0x121, 0xF, 0xF, false)); }
__device__ __forceinline__ float dpp_ror15(float v) { return __builtin_bit_cast(float, __builtin_amdgcn_update_dpp(0, __builtin_bit_cast(int, v), 0x12F, 0xF, 0xF, false)); }
struct EpiFfnUp {
    static constexpr bool PERM = true;
    unsigned char* ws; const float* cw; const float* cb;
    __device__ __forceinline__ void operator()(const f32x4 (&acc)[2][2][4][2], const Unit& u, int wr, int wc, int fr, int fq) const {
        const int c0 = u.pn * 128 + wc * 32 + 8 * fq;
        bf16_t* act = (bf16_t*)(ws + WS_SCR); float* SB = (float*)(ws + WS_SCR + 176 * MiB); const float* RSS = (const float*)(ws + T_RSS);
        f32x4 w0[2], w1[2], w2[2], bb[2];
#pragma unroll
        for (int n = 0; n < 2; ++n) { w0[n] = *(const f32x4*)(cw + c0 + 4 * n); w1[n] = *(const f32x4*)(cw + DFF + c0 + 4 * n); w2[n] = *(const f32x4*)(cw + 2 * DFF + c0 + 4 * n); bb[n] = *(const f32x4*)(cb + c0 + 4 * n); }
        const bool f0 = (fr == 0), f15 = (fr == 15);
        float rsa[2][4];
#pragma unroll
        for (int ai = 0; ai < 2; ++ai)
#pragma unroll
            for (int m = 0; m < 4; ++m) rsa[ai][m] = rstd_of(RSS, (size_t)(u.pm * BM + ai * HALF + wr * 64 + m * 16 + fr));
#pragma unroll
        for (int ai = 0; ai < 2; ++ai) {
            const int G = 4 * u.pm + 2 * ai + wr;
            float rsv[4];
#pragma unroll
            for (int m = 0; m < 4; ++m) rsv[m] = rsa[ai][m];
#pragma unroll
            for (int m = 0; m < 4; ++m) {
                const int row = u.pm * BM + ai * HALF + wr * 64 + m * 16 + fr;
                f32x4 gc[2], gs[2];
#pragma unroll
                for (int n = 0; n < 2; ++n)
#pragma unroll
                    for (int e = 0; e < 4; ++e) {
                        const float gm = acc[ai][0][m][n][e] * rsv[m];
                        const float gprev = (m > 0) ? acc[ai][0][m > 0 ? m - 1 : 0][n][e] * rsv[m > 0 ? m - 1 : 0] : 0.f, gnext = (m < 3) ? acc[ai][0][m < 3 ? m + 1 : 3][n][e] * rsv[m < 3 ? m + 1 : 3] : 0.f;
                        const float pv = dpp_ror1(f15 ? gprev : gm), nv = dpp_ror15(f0 ? gnext : gm);
                        gs[n][e] = gm;
                        gc[n][e] = bb[n][e] + w0[n][e] * pv + w1[n][e] * gm + w2[n][e] * nv;
                    }
                const bool isfirst = (m == 0) && f0, islast = (m == 3) && f15;
                if (isfirst || islast) {
                    float* sp = SB + ((size_t)(islast ? 1 : 0) * 512 + G) * DFF + c0;
#pragma unroll
                    for (int n = 0; n < 2; ++n) { *(f32x4*)(sp + 4 * n) = gc[n]; *(f32x4*)(sp + (size_t)2 * 512 * DFF + 4 * n) = gs[n]; *(f32x4*)(sp + (size_t)4 * 512 * DFF + 4 * n) = acc[ai][1][m][n] * rsv[m]; }
                } else {
                    const f32x2 a0 = gelu_pk((f32x2){gc[0][0], gc[0][1]}), a1 = gelu_pk((f32x2){gc[0][2], gc[0][3]}), a2 = gelu_pk((f32x2){gc[1][0], gc[1][1]}), a3 = gelu_pk((f32x2){gc[1][2], gc[1][3]});
                    const f32x4 u0 = acc[ai][1][m][0] * rsv[m], u1 = acc[ai][1][m][1] * rsv[m];
                    u32x4 w; w.x = cvt_pk_bf16(a0.x * u0[0], a0.y * u0[1]); w.y = cvt_pk_bf16(a1.x * u0[2], a1.y * u0[3]); w.z = cvt_pk_bf16(a2.x * u1[0], a2.y * u1[1]); w.w = cvt_pk_bf16(a3.x * u1[2], a3.y * u1[3]);
                    *(u32x4*)(act + (size_t)row * DFF + c0) = w;
                }
            }
        }
    }
};

template <class Epi, bool ALIGN_EPI = true>
__device__ __forceinline__ void gemm_phase(LAS unsigned char* lds, const Gemm g, const Epi& E, int wv) {
    const int wid = wv, lane = opq(lane_id()), tid = (wid << 6) | lane, wr = wid >> 2, wc = wid & 3, fr = lane & 15, fq = lane >> 4;
    StaticOrder S; S.init(g.nM, g.nN, (int)gridDim.x, (int)blockIdx.x);
    const int K = g.K, nt = K / BK;
    const int a_rs = map_rs(g.amode, g.lda), b_rs = map_rs(g.bmode, g.ldb);
    unsigned voffA[2], voffB[2];
#pragma unroll
    for (int i = 0; i < 2; ++i) { int R, C; stage_rc(tid * 16 + i * 8192, R, C); const int Rb = Epi::PERM ? ((R & ~31) + perm32(R & 31)) : R;
        voffA[i] = (unsigned)(R * a_rs + C) * 2u; voffB[i] = (unsigned)(Rb * b_rs + C) * 2u; }
    const size_t kstep = (size_t)(BK * 2);
    const size_t hstepA = (size_t)map_hs(g.amode, g.lda) * 2, hstepB = (size_t)map_hs(g.bmode, g.ldb) * 2;
    const unsigned ldsw = (unsigned)wid * 1024u;
    const int aoff = lds_byte(wr * 64 + fr, fq * 8), boff = lds_byte(wc * 32 + fr, fq * 8);
#define PG8_SA(b, h) (((b) * 2 + (h)) * HTB)
#define PG8_SB(b, h) ((4 + (b) * 2 + (h)) * HTB)
#define PG8_STAGE(bufoff, gbase, voff) do { _Pragma("unroll") for (int _i = 0; _i < 2; ++_i) \
        __builtin_amdgcn_global_load_lds((const unsigned*)((const char*)(gbase) + (voff)[_i]), (LAS unsigned*)(lds + (bufoff) + ldsw + _i * 8192), 16, 0, 0); } while (0)
#define PG8_LDA(dst, b, h) do { _Pragma("unroll") for (int m = 0; m < 4; ++m) _Pragma("unroll") for (int k = 0; k < 2; ++k) dst[m][k] = *(const LAS bf16x8*)(lds + PG8_SA(b, h) + aoff + m * 2048 + k * 1024); } while (0)
#define PG8_LDB(dst, b, h) do { _Pragma("unroll") for (int n = 0; n < 2; ++n) _Pragma("unroll") for (int k = 0; k < 2; ++k) dst[n][k] = *(const LAS bf16x8*)(lds + PG8_SB(b, h) + boff + n * 2048 + k * 1024); } while (0)
#define PG8_MMA(ai, bj, At, Bt) do { __builtin_amdgcn_s_setprio(1); _Pragma("unroll") for (int m = 0; m < 4; ++m) _Pragma("unroll") for (int n = 0; n < 2; ++n) _Pragma("unroll") for (int k = 0; k < 2; ++k) \
        acc[ai][bj][m][n] = __builtin_amdgcn_mfma_f32_16x16x32_bf16(Bt[n][k], At[m][k], acc[ai][bj][m][n], 0, 0, 0); __builtin_amdgcn_s_setprio(0); } while (0)
#define PG8_WAIT_V(n) asm volatile("s_waitcnt vmcnt(" #n ")" ::: "memory")
#define PG8_WAIT_L(n) asm volatile("s_waitcnt lgkmcnt(" #n ")" ::: "memory")
#define PG8_BAR __builtin_amdgcn_s_barrier()
#define PG8_SCHED __builtin_amdgcn_sched_barrier(0)
    Unit cur, nxt; int ui = 0;
    if (!S.next(0, cur)) return;
    f32x4 acc[2][2][4][2];
#pragma unroll
    for (int a = 0; a < 2; ++a)
#pragma unroll
        for (int b = 0; b < 2; ++b)
#pragma unroll
            for (int m = 0; m < 4; ++m)
#pragma unroll
                for (int n = 0; n < 2; ++n) acc[a][b][m][n] = (f32x4){0.f, 0.f, 0.f, 0.f};
    bf16x8 At[4][2], B0[2][2], B1[2][2];
    const char* cA = (const char*)g.A + map_base(g.amode, cur.pm, cur.pn, g.lda) * 2; const char* cB = (const char*)g.Bt + map_base(g.bmode, cur.pn, cur.pm, g.ldb) * 2;
    PG8_STAGE(PG8_SB(0, 0), cB, voffB); PG8_STAGE(PG8_SB(0, 1), cB + hstepB, voffB); PG8_STAGE(PG8_SA(0, 0), cA, voffA); PG8_STAGE(PG8_SA(0, 1), cA + hstepA, voffA);
    if (wr == 1) PG8_BAR;
    PG8_WAIT_V(2); PG8_BAR;
    PG8_STAGE(PG8_SB(1, 0), cB + kstep, voffB); PG8_STAGE(PG8_SA(1, 0), cA + kstep, voffA); PG8_STAGE(PG8_SB(1, 1), cB + hstepB + kstep, voffB);
    PG8_WAIT_V(6); PG8_BAR;
    for (;;) {
        const bool has_next = S.next(ui + 1, nxt);
        const char* nA = has_next ? (const char*)g.A + map_base(g.amode, nxt.pm, nxt.pn, g.lda) * 2 : cA; const char* nB = has_next ? (const char*)g.Bt + map_base(g.bmode, nxt.pn, nxt.pm, g.ldb) * 2 : cB;
        for (int t = 0; t < nt; t += 2) {
            const bool last = (t == nt - 2);
            const char* a1 = cA + (size_t)(t + 1) * kstep;
            const char* a2 = last ? nA : cA + (size_t)(t + 2) * kstep; const char* b2 = last ? nB : cB + (size_t)(t + 2) * kstep;
            const char* a3 = a2 + kstep; const char* b3 = b2 + kstep;
            PG8_LDB(B0, 0, 0); PG8_LDB(B1, 0, 1); PG8_SCHED; PG8_LDA(At, 0, 0); PG8_STAGE(PG8_SA(1, 1), a1 + hstepA, voffA);
            PG8_WAIT_V(8); PG8_WAIT_L(0); PG8_BAR; PG8_MMA(0, 0, At, B0); PG8_MMA(0, 1, At, B1); PG8_BAR; PG8_SCHED;
            PG8_LDA(At, 0, 1); PG8_STAGE(PG8_SB(0, 0), b2, voffB); PG8_STAGE(PG8_SB(0, 1), b2 + hstepB, voffB); PG8_STAGE(PG8_SA(0, 0), a2, voffA);
            PG8_WAIT_V(8); PG8_WAIT_L(0); PG8_BAR; PG8_MMA(1, 0, At, B0); PG8_MMA(1, 1, At, B1); PG8_BAR; PG8_SCHED;
            PG8_LDB(B0, 1, 0); PG8_LDB(B1, 1, 1); PG8_SCHED; PG8_LDA(At, 1, 0); PG8_STAGE(PG8_SA(0, 1), a2 + hstepA, voffA);
            PG8_WAIT_V(8); PG8_WAIT_L(0); PG8_BAR; PG8_MMA(0, 0, At, B0); PG8_MMA(0, 1, At, B1); PG8_BAR; PG8_SCHED;
            PG8_LDA(At, 1, 1); PG8_STAGE(PG8_SB(1, 0), b3, voffB); PG8_STAGE(PG8_SB(1, 1), b3 + hstepB, voffB); PG8_STAGE(PG8_SA(1, 0), a3, voffA);
            PG8_WAIT_V(8); PG8_WAIT_L(0); PG8_BAR; PG8_MMA(1, 0, At, B0); PG8_MMA(1, 1, At, B1); PG8_BAR; PG8_SCHED;
        }
        if constexpr (ALIGN_EPI) { if (wr == 0) PG8_BAR; }
        E(acc, cur, wr, wc, fr, fq);
        if (!has_next) break;
#pragma unroll
        for (int a = 0; a < 2; ++a)
#pragma unroll
            for (int b = 0; b < 2; ++b)
#pragma unroll
                for (int m = 0; m < 4; ++m)
#pragma unroll
                    for (int n = 0; n < 2; ++n) acc[a][b][m][n] = (f32x4){0.f, 0.f, 0.f, 0.f};
        cur = nxt; cA = nA; cB = nB; ++ui;
        if constexpr (ALIGN_EPI) { if (wr == 1) PG8_BAR; }
    }
    PG8_WAIT_V(0);
    if constexpr (!ALIGN_EPI) { if (wr == 0) PG8_BAR; }
    PG8_BAR;
#undef PG8_SA
#undef PG8_SB
#undef PG8_STAGE
#undef PG8_LDA
#undef PG8_LDB
#undef PG8_MMA
#undef PG8_WAIT_V
#undef PG8_WAIT_L
#undef PG8_BAR
#undef PG8_SCHED
}
}

struct Args { const float* in[29]; float* out; unsigned char* ws; };
enum { I_X = 0, I_POS, I_MIXNORM, I_POOLW, I_POOLS, I_DQKV, I_LQ1, I_LK1, I_LQ2, I_LK2, I_SUBLN, I_DWO, I_LWIN, I_LCW, I_LCB, I_LWA, I_LBA, I_LWX, I_LBX, I_LLAM, I_LWOUT,
       I_XQKV, I_XWO, I_FNORM, I_FUP, I_FCW, I_FCB, I_FDOWN, I_FINAL };

__device__ __forceinline__ int ropeperm(int n) { const int d = n & 63; const int p = d < 32 ? 8 * (d >> 2) + (d & 3) : 8 * ((d - 32) >> 2) + 4 + (d & 3); return (n & ~63) + p; }
__device__ __forceinline__ void transpose_mat(const float* W, int K, int N, int ldn, int c0, bf16_t* WT, int rmode, LAS float* scr, int gw, int NGW, int lane_in, const float* kg = nullptr) {
    const int lane = opq(lane_in) & 63;
    const int nblk = N / 32, items = (K / 64) * nblk;
    for (int item = gw; item < items; item += NGW) {
        const int kb = item / nblk, nb = item % nblk, k0 = 64 * kb, n0 = 32 * nb;
#pragma unroll 16
        for (int i = 0; i < 32; ++i) { const int kk = 2 * i + (lane >> 5); scr[kk * 33 + (lane & 31)] = W[(size_t)(k0 + kk) * ldn + c0 + n0 + (lane & 31)] * (kg ? kg[k0 + kk] : 1.0f); }
        asm volatile("s_waitcnt lgkmcnt(0)" ::: "memory");
        const int c = lane & 7;
#pragma unroll
        for (int j = 0; j < 4; ++j) { const int n = (lane >> 3) + 8 * j; const LAS float* s = scr + (8 * c) * 33 + n;
            u32x4 o; o.x = pk2(s[0 * 33], s[1 * 33]); o.y = pk2(s[2 * 33], s[3 * 33]); o.z = pk2(s[4 * 33], s[5 * 33]); o.w = pk2(s[6 * 33], s[7 * 33]);
            int dn = n0 + n;
            if (rmode == 1) dn = ropeperm(dn);
            else if (rmode == 2) { const int gq = dn / 3072, nl = dn % 3072; dn = gq * 3072 + (nl < 2048 ? ropeperm(nl) : nl); }
            else if (rmode == 3) { const int isu = dn >= DFF ? 1 : 0, nl = dn - isu * DFF; dn = 256 * (nl >> 7) + 128 * isu + (nl & 127); }
            *(u32x4*)(WT + (size_t)dn * K + k0 + 8 * c) = o; }
        asm volatile("s_waitcnt lgkmcnt(0)" ::: "memory");
    }
}
__device__ __forceinline__ void convert_ffn(const Args& a, int layer, LAS float* scr, int gw, int NGW, int lane) {
    transpose_mat(a.in[I_FUP] + (size_t)layer * D * 2 * DFF, D, 2 * DFF, 2 * DFF, 0, (bf16_t*)(a.ws + W_UP), 3, scr, gw, NGW, lane, a.in[I_FNORM] + layer * D);
    transpose_mat(a.in[I_FDOWN] + (size_t)layer * DFF * D, DFF, D, D, 0, (bf16_t*)(a.ws + W_DOWN), 0, scr, gw, NGW, lane);
}
__device__ __forceinline__ void norm_rows(const float* src, const float* gain, bf16_t* dst, int gw, int NGW, int lane_in) {
    const int lane = opq(lane_in) & 63;
    f32x4 gv[4];
#pragma unroll
    for (int j = 0; j < 4; ++j) gv[j] = ((const f32x4*)gain)[lane + 64 * j];
    for (int m = gw; m < M; m += NGW) {
        const f32x4* xr = (const f32x4*)(src + (size_t)m * D) + lane;
        f32x4 v[4]; float s = 0.f;
#pragma unroll
        for (int j = 0; j < 4; ++j) { v[j] = xr[64 * j]; s += (v[j].x * v[j].x + v[j].y * v[j].y) + (v[j].z * v[j].z + v[j].w * v[j].w); }
        const float r = 1.0f / sqrtf(wave_sum(s) * (1.f / D) + 1e-6f);
        u32x2* o8 = (u32x2*)(dst + (size_t)m * D) + lane;
#pragma unroll
        for (int j = 0; j < 4; ++j) { u32x2 w; w.x = pk2(v[j].x * r * gv[j].x, v[j].y * r * gv[j].y); w.y = pk2(v[j].z * r * gv[j].z, v[j].w * r * gv[j].w); o8[64 * j] = w; }
    }
}

constexpr int DA_KP = 272, DA_VP = 144, DA_KOFF = 0, DA_VOFF = 64 * DA_KP, DA_BUF = 64 * DA_KP + 128 * DA_VP, DA_XOFF = 0;

__device__ __forceinline__ void da_qk(f32x16 (&st)[2], const LAS unsigned char* kb, const bf16x8 (&qf)[4]) {
#pragma unroll
    for (int t2 = 0; t2 < 2; ++t2) {
        bf16x8 kf[4];
#pragma unroll
        for (int ks = 0; ks < 4; ++ks) kf[ks] = *(const LAS bf16x8*)(kb + t2 * 32 * DA_KP + ks * 32);
        __builtin_amdgcn_sched_barrier(0);
#pragma unroll
        for (int r = 0; r < 16; ++r) st[t2][r] = 0.f;
#pragma unroll
        for (int ks = 0; ks < 4; ++ks) st[t2] = __builtin_amdgcn_mfma_f32_32x32x16_bf16(kf[ks], qf[ks], st[t2], 0, 0, 0);
    }
}
__device__ __forceinline__ void da_softmax(f32x16 (&st)[2], float& mrun, float& lrun, f32x16 (&ot)[4], bool first, bf16x8 (&pb)[4]) {
    float a = fmaxf(fmaxf(st[0][0], st[0][1]), st[0][2]), b2 = fmaxf(fmaxf(st[1][0], st[1][1]), st[1][2]);
    a = fmaxf(a, st[0][3]); b2 = fmaxf(b2, st[1][3]);
#pragma unroll
    for (int r = 4; r < 16; r += 2) { a = fmaxf(fmaxf(a, st[0][r]), st[0][r + 1]); b2 = fmaxf(fmaxf(b2, st[1][r]), st[1][r + 1]); }
    float mx = fmaxf(a, b2);
    mx = swapmax(mx);
    if (first || __any(mx > mrun + 8.0f)) {
        const float mnew = first ? mx : fmaxf(mx, mrun);
        const float alpha = first ? 0.f : __builtin_amdgcn_exp2f(mrun - mnew);
        lrun *= alpha;
#pragma unroll
        for (int dt = 0; dt < 4; ++dt) ot[dt] = ot[dt] * alpha;
        mrun = mnew;
    }
    float acc0 = 0.f, acc1 = 0.f, acc2 = 0.f, acc3 = 0.f;
#pragma unroll
    for (int t2 = 0; t2 < 2; ++t2)
#pragma unroll
        for (int r = 0; r < 16; r += 4) {
            const float p0 = __builtin_amdgcn_exp2f(st[t2][r] - mrun), p1 = __builtin_amdgcn_exp2f(st[t2][r + 1] - mrun), p2 = __builtin_amdgcn_exp2f(st[t2][r + 2] - mrun), p3 = __builtin_amdgcn_exp2f(st[t2][r + 3] - mrun);
            st[t2][r] = p0; st[t2][r + 1] = p1; st[t2][r + 2] = p2; st[t2][r + 3] = p3;
            acc0 += p0; acc1 += p1; acc2 += p2; acc3 += p3; }
    lrun += (acc0 + acc1) + (acc2 + acc3);
#pragma unroll
    for (int s = 0; s < 4; ++s) { const int t2 = s >> 1, r0 = 8 * (s & 1);
        u32x4 w; w.x = pk2(st[t2][r0], st[t2][r0 + 1]); w.y = pk2(st[t2][r0 + 2], st[t2][r0 + 3]); w.z = pk2(st[t2][r0 + 4], st[t2][r0 + 5]); w.w = pk2(st[t2][r0 + 6], st[t2][r0 + 7]);
        pb[s] = __builtin_bit_cast(bf16x8, w); }
}
__device__ __forceinline__ void da_pv(f32x16 (&ot)[4], const LAS unsigned char* vb, const bf16x8 (&pb)[4]) {
    bf16x8 vn[4];
#pragma unroll
    for (int s = 0; s < 4; ++s) vn[s] = *(const LAS bf16x8*)(vb + 32 * s);
#pragma unroll
    for (int dt = 0; dt < 4; ++dt) {
        bf16x8 vf[4];
#pragma unroll
        for (int s = 0; s < 4; ++s) vf[s] = vn[s];
        if (dt < 3) {
#pragma unroll
            for (int s = 0; s < 4; ++s) vn[s] = *(const LAS bf16x8*)(vb + (dt + 1) * 32 * DA_VP + 32 * s);
        }
        __builtin_amdgcn_sched_barrier(0);
#pragma unroll
        for (int s = 0; s < 4; ++s) ot[dt] = __builtin_amdgcn_mfma_f32_32x32x16_bf16(vf[s], pb[s], ot[dt], 0, 0, 0);
        __builtin_amdgcn_sched_barrier(0);
    }
}
__device__ __forceinline__ void diff_attn_phase(unsigned char* ldsg, const bf16_t* QK, const bf16_t* Vt, bf16_t* O, float lam, float lam_init, const float* subln, int wv) {
    LAS unsigned char* lds = (LAS unsigned char*)ldsg;
    const int wave = wv, lane = opq(lane_id()), tid = (wave << 6) | lane, qg = wave & 3, c = wave >> 2, l31 = lane & 31, hi = lane >> 5;
    const int vb = ((gridDim.x & 7) == 0) ? (int)((blockIdx.x & 7) * (gridDim.x >> 3) + (blockIdx.x >> 3)) : (int)blockIdx.x;
    for (int unit = vb; unit < 2048; unit += gridDim.x) {
        const int b = unit >> 7, hh = (unit >> 4) & 7, qb = unit & 15;
        const size_t rowb = (size_t)b * S;
        const bf16_t* qp = QK + (rowb + qb * 128 + qg * 32 + l31) * 2048 + 128 * hh + 64 * c + 8 * hi;
        bf16x8 qf[4];
#pragma unroll
        for (int ks = 0; ks < 4; ++ks) qf[ks] = *(const bf16x8*)(qp + 16 * ks);
        const bf16_t* kg = QK + rowb * 2048 + 1024 + 128 * hh;
        const bf16_t* vg = Vt + (size_t)(128 * hh) * M + rowb;
        unsigned ksrc[2], vsrc[2]; int kdst[2], vdst[2];
#pragma unroll
        for (int i = 0; i < 2; ++i) { const int id = tid + 512 * i;
            ksrc[i] = (unsigned)((id >> 4) * 2048 + (id & 15) * 8); kdst[i] = DA_KOFF + (id >> 4) * DA_KP + (id & 15) * 16;
            vsrc[i] = (unsigned)((id >> 3) * M + (id & 7) * 8);     vdst[i] = DA_VOFF + (id >> 3) * DA_VP + ((id & 7) >> 1) * 32 + (id & 1) * 8; }
        u32x4 kr[2][2], vr[2][2];
#pragma unroll
        for (int tt = 0; tt < 2; ++tt)
#pragma unroll
            for (int i = 0; i < 2; ++i) { kr[tt][i] = *(const u32x4*)(kg + (size_t)tt * 64 * 2048 + ksrc[i]); vr[tt][i] = *(const u32x4*)(vg + tt * 64 + vsrc[i]); }
        __syncthreads();
#pragma unroll
        for (int tt = 0; tt < 2; ++tt)
#pragma unroll
            for (int i = 0; i < 2; ++i) { *(LAS u32x4*)(lds + tt * DA_BUF + kdst[i]) = kr[tt][i]; *(LAS u32x2*)(lds + tt * DA_BUF + vdst[i]) = (u32x2){vr[tt][i].x, vr[tt][i].y}; *(LAS u32x2*)(lds + tt * DA_BUF + vdst[i] + 16) = (u32x2){vr[tt][i].z, vr[tt][i].w}; }
        __syncthreads();
        f32x16 ot[4];
#pragma unroll
        for (int dt = 0; dt < 4; ++dt)
#pragma unroll
            for (int r = 0; r < 16; ++r) ot[dt][r] = 0.f;
        float mrun = 0.f, lrun = 0.f;
        const LAS unsigned char* kbase = lds + DA_KOFF + l31 * DA_KP + (64 * c + 8 * hi) * 2;
        const LAS unsigned char* vbase = lds + DA_VOFF + l31 * DA_VP + 16 * hi;
        for (int kp = 0; kp < 16; ++kp) {
            if (kp + 1 < 16) {
#pragma unroll
                for (int tt = 0; tt < 2; ++tt)
#pragma unroll
                    for (int i = 0; i < 2; ++i) { kr[tt][i] = *(const u32x4*)(kg + (size_t)(2 * kp + 2 + tt) * 64 * 2048 + ksrc[i]); vr[tt][i] = *(const u32x4*)(vg + (2 * kp + 2 + tt) * 64 + vsrc[i]); }
            }
            f32x16 sa[2];
            bf16x8 pa[4], pb[4];
            da_qk(sa, kbase, qf);
            da_softmax(sa, mrun, lrun, ot, kp == 0, pa);
            __builtin_amdgcn_sched_barrier(0);
            da_qk(sa, kbase + DA_BUF, qf);
            da_pv(ot, vbase, pa);
            __builtin_amdgcn_sched_barrier(0);
            da_softmax(sa, mrun, lrun, ot, false, pb);
            da_pv(ot, vbase + DA_BUF, pb);
            __syncthreads();
            if (kp + 1 < 16) {
#pragma unroll
                for (int tt = 0; tt < 2; ++tt)
#pragma unroll
                    for (int i = 0; i < 2; ++i) { *(LAS u32x4*)(lds + tt * DA_BUF + kdst[i]) = kr[tt][i]; *(LAS u32x2*)(lds + tt * DA_BUF + vdst[i]) = (u32x2){vr[tt][i].x, vr[tt][i].y}; *(LAS u32x2*)(lds + tt * DA_BUF + vdst[i] + 16) = (u32x2){vr[tt][i].z, vr[tt][i].w}; }
            }
            __syncthreads();
        }
        const float ltot = swapsum(lrun);
        const float inv = __builtin_amdgcn_rcpf(ltot);
        LAS float* X = (LAS float*)(lds + DA_XOFF) + (qg * 64) * 64 + lane;
        if (c == 1) {
#pragma unroll
            for (int dt = 0; dt < 4; ++dt)
#pragma unroll
                for (int r = 0; r < 16; ++r) X[(dt * 16 + r) * 64] = ot[dt][r] * inv;
        }
        __syncthreads();
        if (c == 0) {
            float ss = 0.f;
#pragma unroll
            for (int dt = 0; dt < 4; ++dt)
#pragma unroll
                for (int r = 0; r < 16; ++r) { const float o = ot[dt][r] * inv - lam * X[(dt * 16 + r) * 64]; ot[dt][r] = o; ss += o * o; }
            ss = swapsum(ss);
            const float rs = __builtin_amdgcn_rsqf(ss * (1.f / 128.f) + 1e-5f) * (1.0f - lam_init);
            bf16_t* op = O + (rowb + qb * 128 + qg * 32 + l31) * D + 128 * hh;
#pragma unroll
            for (int dt = 0; dt < 4; ++dt)
#pragma unroll
                for (int g4 = 0; g4 < 4; ++g4) { const int d0 = 32 * dt + 8 * g4 + 4 * hi; const f32x4 sg = *(const f32x4*)(subln + d0);
                    u32x2 w; w.x = pk2(ot[dt][4 * g4] * rs * sg[0], ot[dt][4 * g4 + 1] * rs * sg[1]); w.y = pk2(ot[dt][4 * g4 + 2] * rs * sg[2], ot[dt][4 * g4 + 3] * rs * sg[3]);
                    *(u32x2*)(op + d0) = w; }
        }
    }
    __syncthreads();
}

constexpr int DL_KP = 144, DL_VP = 784, DL_VOFF = 384 * DL_KP;
__device__ __forceinline__ void dil_attn_phase(int gi, unsigned char* ldsg, const bf16_t* QKg, const bf16_t* Vtg, float* Oacc, float* LSE, bf16_t* Ofin, int wv) {
    LAS unsigned char* lds = (LAS unsigned char*)ldsg;
    const int wave = wv, lane = opq(lane_id()), tid = (wave << 6) | lane, l31 = lane & 31, hi = lane >> 5;
    const int lgn = (gi == 0) ? 11 : (gi == 1 ? 9 : 7), lgd = 11 - lgn, n = 1 << lgn;
    const int vb = ((gridDim.x & 7) == 0) ? (int)((blockIdx.x & 7) * (gridDim.x >> 3) + (blockIdx.x >> 3)) : (int)blockIdx.x;
    u32x4 vst[6];
#define DL_LOADV(bi_) do { const int i8_ = (bi_) & 7, head_ = ((bi_) >> 3) & 15, b_ = (bi_) >> 7; const int w0_ = 256 * i8_ - 64; \
        _Pragma("unroll") for (int i = 0; i < 6; ++i) { const int id = tid + 512 * i; const int d = id / 48, c16 = id - 48 * d; const int jw = min(max(w0_ + 8 * c16, 0), S - 8); \
            vst[i] = *(const u32x4*)(Vtg + (size_t)(head_ * 64 + d) * M + (size_t)b_ * S + jw); } } while (0)
    if (vb < 2048) DL_LOADV(vb);
    for (int bi = vb; bi < 2048; bi += gridDim.x) {
        const int i8 = bi & 7, head = (bi >> 3) & 15, b = bi >> 7;
        const int J0 = 256 * i8, w0 = J0 - 64;
        const size_t rb = (size_t)b * S;
        __syncthreads();
#pragma unroll
        for (int i = 0; i < 6; ++i) { const int id = tid + 512 * i; const int d = id / 48, c16 = id - 48 * d;
            LAS unsigned char* vd = lds + DL_VOFF + d * DL_VP + (c16 >> 1) * 32 + (c16 & 1) * 8;
            *(LAS u32x2*)vd = (u32x2){vst[i].x, vst[i].y}; *(LAS u32x2*)(vd + 16) = (u32x2){vst[i].z, vst[i].w}; }
        if (bi + (int)gridDim.x < 2048) DL_LOADV(bi + (int)gridDim.x);
        const int jq0 = J0 + 32 * wave, jq = jq0 + l31;
        const int r = jq0 >> lgn, mq = jq & (n - 1);
        const int tq = (mq << lgd) + r;
        const size_t row = rb + tq;
        f32x4 oa[2][4]; float la = 0.f;
#pragma unroll
        for (int dt = 0; dt < 2; ++dt)
#pragma unroll
            for (int g4 = 0; g4 < 4; ++g4) oa[dt][g4] = (f32x4){0.f, 0.f, 0.f, 0.f};
        if (gi > 0) { la = LSE[row * 16 + head];
#pragma unroll
            for (int dt = 0; dt < 2; ++dt)
#pragma unroll
                for (int g4 = 0; g4 < 4; ++g4) oa[dt][g4] = *(const f32x4*)(Oacc + row * D + head * 64 + 32 * dt + 8 * g4 + 4 * hi); }
        const bf16_t* qp = QKg + (rb + jq) * 2048 + head * 64 + 8 * hi;
        bf16x8 qf[4];
#pragma unroll
        for (int ks = 0; ks < 4; ++ks) qf[ks] = *(const bf16x8*)(qp + 16 * ks);
#define DL_LOADK(ti_, dst) do { const int jk0_ = w0 + 32 * wave + 32 * (ti_); const int jkc_ = min(max(jk0_, 0), S - 32); \
            const bf16_t* kpg_ = QKg + (rb + jkc_ + l31) * 2048 + 1024 + head * 64 + 8 * hi; \
            _Pragma("unroll") for (int ks = 0; ks < 4; ++ks) dst[ks] = *(const bf16x8*)(kpg_ + 16 * ks); } while (0)
#define DL_QK(ti_, src) do { const int jk0_ = w0 + 32 * wave + 32 * (ti_); const bool inr_ = (jk0_ >= 0) && (jk0_ < S) && ((jk0_ >> lgn) == r); \
            _Pragma("unroll") for (int rr = 0; rr < 16; ++rr) st[ti_][rr] = 0.f; \
            _Pragma("unroll") for (int ks = 0; ks < 4; ++ks) st[ti_] = __builtin_amdgcn_mfma_f32_32x32x16_bf16(src[ks], qf[ks], st[ti_], 0, 0, 0); \
            _Pragma("unroll") for (int rr = 0; rr < 16; ++rr) { bool ok = inr_; if ((ti_) == 0) ok = ok && (crow(rr, hi) >= l31); if ((ti_) == 4) ok = ok && (crow(rr, hi) <= l31); if (!ok) st[ti_][rr] = -1e30f; } } while (0)
        bf16x8 kA[4], kB[4], kC[4];
        DL_LOADK(0, kA); DL_LOADK(1, kB); DL_LOADK(2, kC);
        __syncthreads();
        f32x16 st[5];
        DL_QK(0, kA); __builtin_amdgcn_sched_barrier(0); DL_LOADK(3, kA); __builtin_amdgcn_sched_barrier(0);
        DL_QK(1, kB); __builtin_amdgcn_sched_barrier(0); DL_LOADK(4, kB); __builtin_amdgcn_sched_barrier(0);
        DL_QK(2, kC); DL_QK(3, kA); DL_QK(4, kB);
#undef DL_LOADK
#undef DL_QK
        float mx = st[2][0];
#pragma unroll
        for (int ti = 0; ti < 5; ++ti)
#pragma unroll
            for (int rr = 0; rr < 16; ++rr) mx = fmaxf(mx, st[ti][rr]);
        mx = swapmax(mx);
        float ps = 0.f;
#pragma unroll
        for (int ti = 0; ti < 5; ++ti)
#pragma unroll
            for (int rr = 0; rr < 16; ++rr) { const float p = __builtin_amdgcn_exp2f(st[ti][rr] - mx); st[ti][rr] = p; ps += p; }
        f32x16 ot[2];
#pragma unroll
        for (int dt = 0; dt < 2; ++dt)
#pragma unroll
            for (int rr = 0; rr < 16; ++rr) ot[dt][rr] = 0.f;
        {
            const LAS unsigned char* vb = lds + DL_VOFF + l31 * DL_VP + 16 * hi + (2 * wave) * 32;
            bf16x8 vfn[2][2];
#pragma unroll
            for (int dt = 0; dt < 2; ++dt)
#pragma unroll
                for (int s2 = 0; s2 < 2; ++s2) vfn[dt][s2] = *(const LAS bf16x8*)(vb + dt * 32 * DL_VP + s2 * 32);
#pragma unroll
            for (int ti = 0; ti < 5; ++ti) {
                bf16x8 vf[2][2];
#pragma unroll
                for (int dt = 0; dt < 2; ++dt)
#pragma unroll
                    for (int s2 = 0; s2 < 2; ++s2) vf[dt][s2] = vfn[dt][s2];
                if (ti < 4) {
#pragma unroll
                    for (int dt = 0; dt < 2; ++dt)
#pragma unroll
                        for (int s2 = 0; s2 < 2; ++s2) vfn[dt][s2] = *(const LAS bf16x8*)(vb + dt * 32 * DL_VP + (2 * (ti + 1) + s2) * 32);
                }
                __builtin_amdgcn_sched_barrier(0);
#pragma unroll
                for (int s2 = 0; s2 < 2; ++s2) { const int r0 = 8 * s2;
                    u32x4 w; w.x = pk2(st[ti][r0], st[ti][r0 + 1]); w.y = pk2(st[ti][r0 + 2], st[ti][r0 + 3]); w.z = pk2(st[ti][r0 + 4], st[ti][r0 + 5]); w.w = pk2(st[ti][r0 + 6], st[ti][r0 + 7]);
                    const bf16x8 pb = __builtin_bit_cast(bf16x8, w);
#pragma unroll
                    for (int dt = 0; dt < 2; ++dt) ot[dt] = __builtin_amdgcn_mfma_f32_32x32x16_bf16(vf[dt][s2], pb, ot[dt], 0, 0, 0); }
                __builtin_amdgcn_sched_barrier(0);
            }
        }
        const float ltot = swapsum(ps);
        const float inv = __builtin_amdgcn_rcpf(ltot);
        float lse2 = mx + __builtin_amdgcn_logf(ltot);
        float wa = 0.f, wg = inv;
        if (gi > 0) { const float mxl = fmaxf(la, lse2);
            const float ea = __builtin_amdgcn_exp2f(la - mxl), eg = __builtin_amdgcn_exp2f(lse2 - mxl); const float den = __builtin_amdgcn_rcpf(ea + eg);
            wa = ea * den; wg = eg * den * inv; lse2 = mxl + __builtin_amdgcn_logf(ea + eg); }
        if (gi < 2 && hi == 0) LSE[row * 16 + head] = lse2;
#pragma unroll
        for (int dt = 0; dt < 2; ++dt)
#pragma unroll
            for (int g4 = 0; g4 < 4; ++g4) { const int d0 = head * 64 + 32 * dt + 8 * g4 + 4 * hi;
                f32x4 o = (f32x4){ot[dt][4 * g4], ot[dt][4 * g4 + 1], ot[dt][4 * g4 + 2], ot[dt][4 * g4 + 3]} * wg;
                if (gi > 0) o += oa[dt][g4] * wa;
                if (gi < 2) *(f32x4*)(Oacc + row * D + d0) = o;
                else { u32x2 w; w.x = pk2(o[0], o[1]); w.y = pk2(o[2], o[3]); *(u32x2*)(Ofin + row * D + d0) = w; } }
    }
    __syncthreads();
#undef DL_LOADV
}

template <int CTRL, int ROWMASK> __device__ __forceinline__ float dppf(float oldv, float v) {
    return __builtin_bit_cast(float, __builtin_amdgcn_update_dpp(__builtin_bit_cast(int, oldv), __builtin_bit_cast(int, v), CTRL, ROWMASK, 0xF, false)); }
template <int CTRL, int ROWMASK> __device__ __forceinline__ void scan_step(float& a, float& b) {
    const float ap = dppf<CTRL, ROWMASK>(1.0f, a), bp = dppf<CTRL, ROWMASK>(0.0f, b);
    b = a * bp + b; a = a * ap;
}
__device__ __forceinline__ float sigmoidf_(float x) { return __builtin_amdgcn_rcpf(1.0f + __builtin_amdgcn_exp2f(-1.4426950408889634f * x)); }
__device__ __forceinline__ void lru_phase(int mode, unsigned char* ldsg, const Args& a, const bf16_t* GU2, const bf16_t* Wfrag, float* AGG, bf16_t* Y, int gw, int NGW, int wave, int lane_in) {
    const int lane = opq(lane_in) & 63;
    LAS float* wl = (LAS float*)((LAS unsigned char*)ldsg + wave * 4096);
    const int tok = lane & 31, hi = lane >> 5;
    int staged_n = -1;
    float* Af = AGG; float* Hf = AGG + (size_t)NB * 64 * 1024; float* Ab = Hf + (size_t)NB * 64 * 1024; float* Hb = Ab + (size_t)NB * 64 * 1024;
    const float* Cf = Hb + (size_t)NB * 64 * 1024; const float* Cb = Cf + (size_t)NB * 64 * 1024;
    for (int item = gw; item < 16 * 16 * 64; item += NGW) {
        const int b = item >> 10, n = (item >> 6) & 15, chunk = item & 63;
        if (n != staged_n) {
            staged_n = n;
            const int ch = 64 * n + lane;
#pragma unroll
            for (int d = 0; d < 2; ++d) {
#pragma unroll
                for (int j = 0; j < 4; ++j) wl[(d * 4 + j) * 64 + lane] = a.in[I_LCW][(d * 4 + j) * 1024 + ch];
                wl[(8 + d) * 64 + lane] = a.in[I_LCB][d * 1024 + ch];
                wl[(10 + d) * 64 + lane] = -1.4426950408889634f * a.in[I_LBA][d * 1024 + ch];
                wl[(12 + d) * 64 + lane] = -1.4426950408889634f * a.in[I_LBX][d * 1024 + ch];
                wl[(14 + d) * 64 + lane] = -11.541560327111707f * log1pf(expf(-a.in[I_LLAM][d * 1024 + ch]));
            }
            asm volatile("s_waitcnt lgkmcnt(0)" ::: "memory");
        }
        const int t = 32 * chunk + tok;
        float hsum[32];
#pragma unroll
        for (int cc = 0; cc < 32; ++cc) hsum[cc] = 0.f;
#pragma unroll 1
        for (int d = 0; d < 2; ++d) {
            float xc[32];
#pragma unroll
            for (int q = 0; q < 8; ++q) { const f32x4 bv = *(const LAS f32x4*)(wl + (8 + d) * 64 + 32 * hi + 4 * q); xc[4 * q] = bv[0]; xc[4 * q + 1] = bv[1]; xc[4 * q + 2] = bv[2]; xc[4 * q + 3] = bv[3]; }
#pragma unroll
            for (int j = 0; j < 4; ++j) {
                const int tt = (d == 0) ? (t - 3 + j) : (t + 3 - j);
                if (tt >= 0 && tt < S) {
                    const bf16_t* up = GU2 + ((size_t)b * S + tt) * 2048 + 1024 + 64 * n + 32 * hi;
#pragma unroll
                    for (int q = 0; q < 4; ++q) { const u32x4 uv = *(const u32x4*)(up + 8 * q);
                        const f32x4 w0 = *(const LAS f32x4*)(wl + (d * 4 + j) * 64 + 32 * hi + 8 * q), w1 = *(const LAS f32x4*)(wl + (d * 4 + j) * 64 + 32 * hi + 8 * q + 4);
                        xc[8 * q + 0] += w0[0] * bflo(uv.x); xc[8 * q + 1] += w0[1] * bfhi(uv.x); xc[8 * q + 2] += w0[2] * bflo(uv.y); xc[8 * q + 3] += w0[3] * bfhi(uv.y);
                        xc[8 * q + 4] += w1[0] * bflo(uv.z); xc[8 * q + 5] += w1[1] * bfhi(uv.z); xc[8 * q + 6] += w1[2] * bflo(uv.w); xc[8 * q + 7] += w1[3] * bfhi(uv.w); }
                }
            }
            bf16x8 bx[4];
#pragma unroll
            for (int ks = 0; ks < 4; ++ks) { u32x4 w; w.x = pk2(xc[8 * ks], xc[8 * ks + 1]); w.y = pk2(xc[8 * ks + 2], xc[8 * ks + 3]); w.z = pk2(xc[8 * ks + 4], xc[8 * ks + 5]); w.w = pk2(xc[8 * ks + 6], xc[8 * ks + 7]); bx[ks] = __builtin_bit_cast(bf16x8, w); }
#pragma unroll
            for (int jt = 0; jt < 2; ++jt) {
                __builtin_amdgcn_sched_barrier(0);
                f32x16 pre[2];
#pragma unroll
                for (int gt = 0; gt < 2; ++gt) {
#pragma unroll
                    for (int rr = 0; rr < 16; ++rr) pre[gt][rr] = 0.f;
#pragma unroll
                    for (int ks = 0; ks < 4; ++ks) { const bf16x8 wf = *(const bf16x8*)(Wfrag + ((size_t)((((d * 16 + n) * 2 + gt) * 2 + jt) * 4 + ks) * 64 + lane) * 8);
                        pre[gt] = __builtin_amdgcn_mfma_f32_32x32x16_bf16(wf, bx[ks], pre[gt], 0, 0, 0); }
                }
                float av[16], bv[16];
#pragma unroll
                for (int rr = 0; rr < 16; ++rr) { const int cc = 16 * jt + rr; const int ch = 32 * hi + cc;
                    const float ra = __builtin_amdgcn_rcpf(1.0f + __builtin_amdgcn_exp2f(pre[0][rr] + wl[(10 + d) * 64 + ch])), ix = __builtin_amdgcn_rcpf(1.0f + __builtin_amdgcn_exp2f(pre[1][rr] + wl[(12 + d) * 64 + ch]));
                    const float la2 = ra * wl[(14 + d) * 64 + ch];
                    av[rr] = __builtin_amdgcn_exp2f(la2); bv[rr] = __builtin_amdgcn_sqrtf(fmaxf(1.0f - __builtin_amdgcn_exp2f(la2 + la2), 0.f)) * ix * xc[cc]; }
#define SCAN_DPP(a_, b_, DPPSTR) asm volatile("s_nop 1\n\tv_fmac_f32_dpp %0, %0, %1 " DPPSTR "\n\tv_mul_f32_dpp %1, %1, %1 " DPPSTR : "+v"(b_), "+v"(a_))
#define SCAN_ALL(DPPSTR) do { _Pragma("unroll") for (int rr = 0; rr < 16; ++rr) SCAN_DPP(av[rr], bv[rr], DPPSTR); } while (0)
                asm volatile("s_nop 1" ::: "memory");
                if (d == 0) {
                    SCAN_ALL("row_shr:1 row_mask:0xf bank_mask:0xf"); SCAN_ALL("row_shr:2 row_mask:0xf bank_mask:0xf"); SCAN_ALL("row_shr:4 row_mask:0xf bank_mask:0xf"); SCAN_ALL("row_shr:8 row_mask:0xf bank_mask:0xf");
                    SCAN_ALL("row_bcast:15 row_mask:0xa bank_mask:0xf");
                } else {
                    SCAN_ALL("row_shl:1 row_mask:0xf bank_mask:0xf"); SCAN_ALL("row_shl:2 row_mask:0xf bank_mask:0xf"); SCAN_ALL("row_shl:4 row_mask:0xf bank_mask:0xf"); SCAN_ALL("row_shl:8 row_mask:0xf bank_mask:0xf");
                    const bool lowrow = (lane & 16) == 0;
#pragma unroll
                    for (int rr = 0; rr < 16; ++rr) {
                        const float a16 = __builtin_bit_cast(float, __builtin_amdgcn_readlane(__builtin_bit_cast(int, av[rr]), 16)), a48 = __builtin_bit_cast(float, __builtin_amdgcn_readlane(__builtin_bit_cast(int, av[rr]), 48));
                        const float b16 = __builtin_bit_cast(float, __builtin_amdgcn_readlane(__builtin_bit_cast(int, bv[rr]), 16)), b48 = __builtin_bit_cast(float, __builtin_amdgcn_readlane(__builtin_bit_cast(int, bv[rr]), 48));
                        const float ap = lowrow ? (hi ? a48 : a16) : 1.0f, bp = lowrow ? (hi ? b48 : b16) : 0.0f;
                        bv[rr] = av[rr] * bp + bv[rr]; av[rr] = av[rr] * ap;
                    }
                }
#undef SCAN_ALL
#undef SCAN_DPP
                if (mode == 0) {
                    const bool w = (d == 0) ? (tok == 31) : (tok == 0);
                    if (w) { float* pa = (d == 0 ? Af : Ab) + ((size_t)b * 64 + chunk) * 1024 + 64 * n + 32 * hi + 16 * jt; float* ph = (d == 0 ? Hf : Hb) + ((size_t)b * 64 + chunk) * 1024 + 64 * n + 32 * hi + 16 * jt;
#pragma unroll
                        for (int q = 0; q < 4; ++q) { *(f32x4*)(pa + 4 * q) = (f32x4){av[4 * q], av[4 * q + 1], av[4 * q + 2], av[4 * q + 3]}; *(f32x4*)(ph + 4 * q) = (f32x4){bv[4 * q], bv[4 * q + 1], bv[4 * q + 2], bv[4 * q + 3]}; } }
                } else {
#pragma unroll
                    for (int q = 0; q < 4; ++q) { const f32x4 cv = *(const f32x4*)((d == 0 ? Cf : Cb) + ((size_t)b * 64 + chunk) * 1024 + 64 * n + 32 * hi + 16 * jt + 4 * q);
#pragma unroll
                        for (int e = 0; e < 4; ++e) hsum[16 * jt + 4 * q + e] += bv[4 * q + e] + av[4 * q + e] * cv[e]; }
                }
            }
        }
        if (mode == 1) {
            const size_t row = (size_t)b * S + t;
            const bf16_t* gp = GU2 + row * 2048 + 64 * n + 32 * hi;
            bf16_t* yp = Y + row * D + 64 * n + 32 * hi;
#pragma unroll
            for (int q = 0; q < 4; ++q) { const u32x4 gv = *(const u32x4*)(gp + 8 * q);
                float gx[8] = {bflo(gv.x), bfhi(gv.x), bflo(gv.y), bfhi(gv.y), bflo(gv.z), bfhi(gv.z), bflo(gv.w), bfhi(gv.w)};
                float yv[8];
#pragma unroll
                for (int e = 0; e < 8; ++e) { const float x = gx[e]; const float z = 0.7978845608028654f * (x + 0.044715f * x * x * x); yv[e] = (x * __builtin_amdgcn_rcpf(1.0f + __builtin_amdgcn_exp2f(-2.8853900817779268f * z))) * hsum[8 * q + e]; }
                u32x4 w; w.x = pk2(yv[0], yv[1]); w.y = pk2(yv[2], yv[3]); w.z = pk2(yv[4], yv[5]); w.w = pk2(yv[6], yv[7]);
                *(u32x4*)(yp + 8 * q) = w; }
        }
    }
}


__device__ __forceinline__ void lru_carry(float* AGG, int tid_in) {
    const int e = (int)blockIdx.x * NT + opq(tid_in);
    if (e < 2 * NB * 1024) {
    const int ch = e & 1023, b = (e >> 10) & 15, d = e >> 14;
    const size_t plane = (size_t)NB * 64 * 1024;
    const float* A = AGG + (d == 0 ? 0 : 2 * plane); const float* Hh = A + plane; float* C = AGG + (4 + d) * plane;
    float c = 0.f;
#pragma unroll 1
    for (int k0 = 0; k0 < 64; k0 += 16) {
        float av[16], hv[16];
#pragma unroll
        for (int j = 0; j < 16; ++j) { const int k = (d == 0) ? (k0 + j) : (63 - k0 - j); const size_t o = ((size_t)b * 64 + k) * 1024 + ch; av[j] = A[o]; hv[j] = Hh[o]; }
#pragma unroll
        for (int j = 0; j < 16; ++j) { const int k = (d == 0) ? (k0 + j) : (63 - k0 - j); C[((size_t)b * 64 + k) * 1024 + ch] = c; c = av[j] * c + hv[j]; }
    }
    }
}


template <int G> __device__ __forceinline__ void pool_group8(const float* x, const float* rstd0, const float* gain, bf16_t* MO, size_t rb, int t0, int lane) {
    constexpr int HALF = 1 << G, WIN = 2 * HALF, NR = WIN + 7;
    f32x4 rowv[NR];
#pragma unroll
    for (int i = 0; i < NR; ++i) { const int tt = t0 - HALF + i;
        rowv[i] = (tt >= 0 && tt < S) ? *((const f32x4*)(x + (rb + tt) * D + 256 * G) + lane) * rstd0[rb + tt] : (f32x4){0.f, 0.f, 0.f, 0.f}; }
    const f32x4 gv = *((const f32x4*)(gain + 256 * G) + lane);
    f32x4 sum = (f32x4){0.f, 0.f, 0.f, 0.f};
#pragma unroll
    for (int i = 0; i < WIN; ++i) sum += rowv[i];
#pragma unroll
    for (int j = 0; j < 8; ++j) { const int t = t0 + j; const int lo = max(t - HALF, 0), hi = min(t + HALF, S);
        const f32x4 p = (sum * (1.0f / (float)(hi - lo)) - rowv[j + HALF]) * gv;
        u32x2 w; w.x = pk2(p[0], p[1]); w.y = pk2(p[2], p[3]);
        *((u32x2*)(MO + (rb + t) * D + 256 * G) + lane) = w;
        if (j < 7) sum += rowv[j + WIN] - rowv[j]; }
}

#ifndef GMASK
#define GMASK 0xffff
#endif
#define GSITE(n, stmt) do { if constexpr ((GMASK >> (n)) & 1) { stmt; } } while (0)

#define XB_TMO      128
#define XB_XCNT(j)  (256  + 64 * (j))
#define XB_XSUB(j)  (1280 + 64 * (j))
#define XB_XGEN(j)  (2304 + 64 * (j))
#define XB_TOP      3328
#define XB_TOPGEN   3392
#define XCD_BAR_WORDS 3456
#define XB_SPIN_CAP (1u << 18)
__device__ __forceinline__ unsigned xb_ld(unsigned* p)              { return __hip_atomic_load(p, __ATOMIC_RELAXED, __HIP_MEMORY_SCOPE_AGENT); }
__device__ __forceinline__ unsigned xb_add(unsigned* p, unsigned v) { return __hip_atomic_fetch_add(p, v, __ATOMIC_RELAXED, __HIP_MEMORY_SCOPE_AGENT); }
__device__ __forceinline__ unsigned xb_xcc_id() { return (unsigned)__builtin_amdgcn_s_getreg((3 << 11) | 20) & 0xFu; }
#define XB_SPIN(cond, bar) do { unsigned _sp = 0; while (cond) { __builtin_amdgcn_s_sleep(1); \
    if ((++_sp & 255u) == 0u) { if (xb_ld(&(bar)[XB_TMO])) break; if (_sp > XB_SPIN_CAP) { atomicAdd(&(bar)[XB_TMO], 1u); break; } } } } while (0)
struct XcdBarrier { unsigned* bar; unsigned x; volatile LAS unsigned* st; };
__device__ __forceinline__ XcdBarrier xcd_barrier_post(unsigned* bar, volatile LAS unsigned* st, bool leader) {
    XcdBarrier b; b.bar = bar; b.x = xb_xcc_id(); b.st = st;
    if (leader) (void)xb_add(&bar[XB_XCNT(b.x)], 1u);
    return b;
}
__device__ __forceinline__ void xcd_barrier_complete(unsigned* bar, unsigned x, unsigned& nloc, unsigned& nx) {
    const unsigned G = gridDim.x * gridDim.y * gridDim.z;
    unsigned sum, cnt, mine, sp = 0u;
    for (;;) {
        sum = 0u; cnt = 0u; mine = 0u;
#pragma unroll 1
        for (unsigned j = 0; j < 16; ++j) { const unsigned c = xb_ld(&bar[XB_XCNT(j)]); sum += c; cnt += (c > 0u) ? 1u : 0u; mine = (j == x) ? c : mine; }
        if (sum == G) break;
        __builtin_amdgcn_s_sleep(1);
        if ((++sp & 255u) == 0u) { if (xb_ld(&bar[XB_TMO])) break; if (sp > XB_SPIN_CAP) { atomicAdd(&bar[XB_TMO], 1u); break; } }
    }
    nloc = mine > 0u ? mine : 1u; nx = cnt > 0u ? cnt : 1u;
}
__device__ __forceinline__ void xcd_barrier(const XcdBarrier& b, bool leader) {
    asm volatile("s_waitcnt vmcnt(0)" ::: "memory");
    __syncthreads();
    if (leader) {
        unsigned* bar = b.bar;
        __builtin_amdgcn_s_waitcnt(0);
        unsigned nloc = b.st[0], nx = b.st[1];
        if (nloc == 0u) { xcd_barrier_complete(bar, b.x, nloc, nx); b.st[0] = nloc; b.st[1] = nx; }
        const unsigned old = xb_add(&bar[XB_XSUB(b.x)], 1u);
        const unsigned gen = old / nloc;
        if (old + 1u == (gen + 1u) * nloc) {
            __builtin_amdgcn_fence(__ATOMIC_RELEASE, "agent");
            asm volatile("s_waitcnt vmcnt(0)" ::: "memory");
            const unsigned og = xb_add(&bar[XB_TOP], 1u);
            const unsigned tg = og / nx;
            if (og + 1u == (tg + 1u) * nx) xb_add(&bar[XB_TOPGEN], 1u);
            else XB_SPIN(xb_ld(&bar[XB_TOPGEN]) == tg, bar);
            __builtin_amdgcn_fence(__ATOMIC_ACQUIRE, "agent");
            xb_add(&bar[XB_XGEN(b.x)], 1u);
            asm volatile("s_waitcnt vmcnt(0)" ::: "memory");
        } else {
            XB_SPIN(xb_ld(&bar[XB_XGEN(b.x)]) == gen, bar);
            __builtin_amdgcn_fence(__ATOMIC_ACQUIRE, "agent");
            asm volatile("s_waitcnt vmcnt(0)" ::: "memory");
        }
    }
    __syncthreads();
}

#ifdef PROBE
#define TICK(k) do { const unsigned long long now_ = __builtin_amdgcn_s_memrealtime(); cls[k] += (unsigned)(now_ - tlast); tlast = now_; } while (0)
#else
#define TICK(k) do {} while (0)
#endif
#define PSYNC(k) do { TICK(k); { XcdBarrier xb_; xb_.bar = (unsigned*)(a.ws + T_CTL); xb_.x = xb_xcc_id(); xb_.st = (volatile LAS unsigned*)(ldsl + 131072 + 1024); xcd_barrier(xb_, wave == 0 && lane_id() == 0); } TICK(0); } while (0)
__global__ void __launch_bounds__(NT, 2) fwd(Args a) {
    extern __shared__ __attribute__((aligned(16))) unsigned char lds[];
    cg::grid_group grid = cg::this_grid();
    const int wave = __builtin_amdgcn_readfirstlane((int)threadIdx.x >> 6);
#define tid ((wave << 6) | lane_id())
    const int gw = blockIdx.x * 8 + wave, NGW = gridDim.x * 8;
    LAS unsigned char* ldsl = (LAS unsigned char*)lds;
    LAS float* scr = (LAS float*)(ldsl + wave * 16384);
    unsigned char* ws = a.ws;
    bf16_t* XN = (bf16_t*)(ws + WS_XN); bf16_t* MO = (bf16_t*)(ws + WS_MO); float* RSS = (float*)(ws + T_RSS);
    float* cosT = (float*)(ws + T_COS); float* sinT = (float*)(ws + T_SIN); float* rstd0 = (float*)(ws + T_RSTD);
    float* H = a.out;
    volatile LAS unsigned* misc = (volatile LAS unsigned*)(ldsl + 131072 + 1024);
    if (tid < 2) misc[tid] = 0u;
    __syncthreads();
    (void)xcd_barrier_post((unsigned*)(ws + T_CTL), misc, wave == 0 && lane_id() == 0);
#ifdef PROBE
    unsigned cls[8] = {0, 0, 0, 0, 0, 0, 0, 0}; unsigned long long tlast = __builtin_amdgcn_s_memrealtime();
#endif

    {
        for (int g = 0; g < 4; ++g) transpose_mat(a.in[I_POOLW] + (size_t)g * 65536, 256, 256, 256, 0, (bf16_t*)(ws + W_POOL) + (size_t)g * 65536, 0, scr, gw, NGW, tid);
        transpose_mat(a.in[I_DQKV], D, 2048, 3072, 0, (bf16_t*)(ws + W_DQK), 1, scr, gw, NGW, tid, a.in[I_MIXNORM] + 1 * D);
        transpose_mat(a.in[I_DQKV], D, 1024, 3072, 2048, (bf16_t*)(ws + W_DV), 0, scr, gw, NGW, tid, a.in[I_MIXNORM] + 1 * D);
        transpose_mat(a.in[I_DWO], D, D, D, 0, (bf16_t*)(ws + W_DO), 0, scr, gw, NGW, tid);
        transpose_mat(a.in[I_LWIN], D, 2048, 2048, 0, (bf16_t*)(ws + W_LIN), 0, scr, gw, NGW, tid, a.in[I_MIXNORM] + 2 * D);
        transpose_mat(a.in[I_LWOUT], D, D, D, 0, (bf16_t*)(ws + W_LOUT), 0, scr, gw, NGW, tid);
        transpose_mat(a.in[I_XQKV], D, 9216, 9216, 0, (bf16_t*)(ws + W_XQKV), 2, scr, gw, NGW, tid, a.in[I_MIXNORM] + 3 * D);
        transpose_mat(a.in[I_XWO], D, D, D, 0, (bf16_t*)(ws + W_XO), 0, scr, gw, NGW, tid);
        convert_ffn(a, 0, scr, gw, NGW, tid);
        for (int e = blockIdx.x * NT + tid; e < 2 * 16 * 2 * 2 * 4 * 64; e += gridDim.x * NT) {
            const int ln = e & 63, ks = (e >> 6) & 3, jt = (e >> 8) & 1, gt = (e >> 9) & 1, n = (e >> 10) & 15, d = e >> 14;
            const int rho = (ln & 31) + 32 * jt, hi = ln >> 5;
            const int jout = 32 * ((rho >> 2) & 1) + 4 * (rho >> 3) + (rho & 3);
            const float* Wg = (gt == 0 ? a.in[I_LWA] : a.in[I_LWX]) + (size_t)(d * 16 + n) * 4096;
            u32x4 w; float v[8];
#pragma unroll
            for (int j8 = 0; j8 < 8; ++j8) v[j8] = -1.4426950408889634f * Wg[(32 * hi + 8 * ks + j8) * 64 + jout];
            w.x = pk2(v[0], v[1]); w.y = pk2(v[2], v[3]); w.z = pk2(v[4], v[5]); w.w = pk2(v[6], v[7]);
            *(u32x4*)((bf16_t*)(ws + W_LG) + (size_t)e * 8) = w;
        }
        for (int e = blockIdx.x * NT + tid; e < S * 32; e += gridDim.x * NT) {
            const int t = e >> 5, i = e & 31;
            const float inv = exp2f(-(float)i * (13.287712379549449f / 32.0f));
            const float ang = (float)((const int*)a.in[I_POS])[t] * inv;
            cosT[e] = cosf(ang); sinT[e] = sinf(ang);
        }
        const int lane = opq(tid) & 63;
        for (int m = gw; m < M; m += NGW) {
            const f32x4* xr = (const f32x4*)(a.in[I_X] + (size_t)m * D) + lane; float s = 0.f;
#pragma unroll
            for (int j = 0; j < 4; ++j) { const f32x4 v = xr[64 * j]; s += (v.x * v.x + v.y * v.y) + (v.z * v.z + v.w * v.w); }
            s = wave_sum(s);
            if (lane == 0) rstd0[m] = 1.0f / sqrtf(s * (1.f / D) + 1e-6f);
        }
    }
    TICK(7); grid.sync(); TICK(0);

    for (int layer = 0; layer < 4; ++layer) {
        if (layer == 0) {
            const float* x = a.in[I_X]; const float* gain = a.in[I_MIXNORM]; const int lane = (opq(tid) & 63);
            for (int m8 = gw; m8 < M / 8; m8 += NGW) {
                const int m0 = 8 * m8, t0 = m0 & (S - 1); const size_t rb = (size_t)(m0 - t0);
                pool_group8<0>(x, rstd0, gain, MO, rb, t0, lane); pool_group8<1>(x, rstd0, gain, MO, rb, t0, lane);
                pool_group8<2>(x, rstd0, gain, MO, rb, t0, lane); pool_group8<3>(x, rstd0, gain, MO, rb, t0, lane);
            }
            PSYNC(7);
        } else {
            convert_ffn(a, layer, scr, gw, NGW, tid);
            __syncthreads();
            if (layer == 1) {
                bf16_t* QK = (bf16_t*)(ws + WS_SCR); bf16_t* Vt = (bf16_t*)(ws + WS_SCR + 128 * MiB);
                { pg8::Gemm g{XN, (const bf16_t*)(ws + W_DQK), D, D, D, 0, 0, 128, 8}; pg8::EpiRope E{ws, 0, QSCALE}; GSITE(1, pg8::gemm_phase(ldsl, g, E, wave)); }
                { pg8::Gemm g{(const bf16_t*)(ws + W_DV), XN, D, D, D, 0, 0, 4, 128}; pg8::EpiPlain E{ws, WS_SCR + 128 * MiB, (size_t)M, 2, 0}; GSITE(2, pg8::gemm_phase(ldsl, g, E, wave)); }
                PSYNC(1);
                float s1 = 0.f, s2 = 0.f;
                for (int i = 0; i < 64; ++i) { s1 += a.in[I_LQ1][i] * a.in[I_LK1][i]; s2 += a.in[I_LQ2][i] * a.in[I_LK2][i]; }
                const float lam_init = 0.8f - 0.6f * expf(-0.3f * 1.0f);
                const float lam = expf(s1) - expf(s2) + lam_init;
#ifndef NO_DIFF
                diff_attn_phase(lds, QK, Vt, MO, lam, lam_init, a.in[I_SUBLN], wave);
#endif
                PSYNC(4);
            } else if (layer == 2) {
                bf16_t* GU2 = (bf16_t*)(ws + WS_SCR);
                { pg8::Gemm g{XN, (const bf16_t*)(ws + W_LIN), D, D, D, 0, 0, 128, 8}; pg8::EpiPlain E{ws, WS_SCR, 2048, 1, 0}; GSITE(3, pg8::gemm_phase(ldsl, g, E, wave)); }
                PSYNC(1);
#ifndef NO_LRU
                lru_phase(0, lds, a, GU2, (const bf16_t*)(ws + W_LG), (float*)(ws + T_AGG), MO, gw, NGW, wave, tid);
#endif
                PSYNC(5);
                lru_carry((float*)(ws + T_AGG), tid);
                PSYNC(5);
#ifndef NO_LRU
                lru_phase(1, lds, a, GU2, (const bf16_t*)(ws + W_LG), (float*)(ws + T_AGG), MO, gw, NGW, wave, tid);
#endif
                PSYNC(5);
            } else {
                bf16_t* QKg = (bf16_t*)(ws + WS_SCR); bf16_t* Vtg = (bf16_t*)(ws + WS_SCR + 128 * MiB); float* Oacc = (float*)(ws + WS_SCR + 192 * MiB); float* LSE = (float*)(ws + T_LSE);
                for (int gi = 0; gi < 3; ++gi) {
                    const bf16_t* Wg = (const bf16_t*)(ws + W_XQKV) + (size_t)gi * 3072 * D;
                    { pg8::Gemm g{XN, Wg, D, D, D, gi, 0, 128, 8}; pg8::EpiRope E{ws, gi, QSCALE}; GSITE(4, pg8::gemm_phase(ldsl, g, E, wave)); }
                    { pg8::Gemm g{Wg + (size_t)2048 * D, XN, D, D, D, 0, gi, 4, 128}; pg8::EpiPlain E{ws, WS_SCR + 128 * MiB, (size_t)M, 2, gi}; GSITE(5, pg8::gemm_phase(ldsl, g, E, wave)); }
                    PSYNC(1);
#ifndef NO_DIL
                    dil_attn_phase(gi, lds, QKg, Vtg, Oacc, LSE, MO, wave);
#endif
                    PSYNC(6);
                }
            }
        }
        {
            pg8::Gemm g{MO, (const bf16_t*)(ws + (layer == 0 ? W_POOL : layer == 1 ? W_DO : layer == 2 ? W_LOUT : W_XO)), layer == 0 ? 256 : D, D, layer == 0 ? 256 : D, layer == 0 ? 3 : 0, 0, 128, 4};
            pg8::EpiResid E{layer == 0 ? a.in[I_X] : nullptr, layer == 0 ? a.in[I_POOLS] : nullptr, ws, (LAS float*)(ldsl + 133120)};
            GSITE(6, pg8::gemm_phase(ldsl, g, E, wave));
        }
        PSYNC(1);
        bf16_t* ACT = (bf16_t*)(ws + WS_SCR); float* SB = (float*)(ws + WS_SCR + 176 * MiB);
        const float* cw = a.in[I_FCW] + (size_t)layer * 3 * DFF; const float* cb = a.in[I_FCB] + (size_t)layer * DFF;
        { pg8::Gemm g{XN, (const bf16_t*)(ws + W_UP), D, D, D, 0, 0, 128, 22}; pg8::EpiFfnUp E{ws, cw, cb}; GSITE(7, pg8::gemm_phase(ldsl, g, E, wave)); }
        PSYNC(1);
        {
            const int tidl = opq(tid);
            pg8::StaticOrder So; So.init(128, 4, (int)gridDim.x, (int)blockIdx.x); pg8::Unit uu;
            for (int i = 0; So.next(i, uu); ++i) {
                for (int idx = tidl; idx < 8 * (DFF / 8); idx += NT) {
                    const int rk = idx / (DFF / 8), c0 = 8 * (idx % (DFF / 8)); const int k = rk >> 1, last = rk & 1;
                    const int G = 4 * uu.pm + k; const int row = 64 * G + (last ? 63 : 0); const int t = row & (S - 1);
                    const float* pp = SB + ((size_t)last * 512 + G) * DFF + c0;
                    const bool hasn = last ? (t < S - 1) : (t > 0);
                    const float* nb = SB + ((size_t)(last ? 2 : 3) * 512 + (last ? G + 1 : G - 1)) * DFF + c0;
                    const float* wt = cw + (last ? 2 * DFF : 0) + c0;
                    float o[8];
#pragma unroll
                    for (int h2 = 0; h2 < 2; ++h2) {
                        f32x4 p = *(const f32x4*)(pp + 4 * h2); const f32x4 uv = *(const f32x4*)(pp + (size_t)4 * 512 * DFF + 4 * h2);
                        if (hasn) p += *(const f32x4*)(wt + 4 * h2) * *(const f32x4*)(nb + 4 * h2);
                        const f32x2 a0 = gelu_pk((f32x2){p[0], p[1]}), a1 = gelu_pk((f32x2){p[2], p[3]});
                        o[4 * h2] = a0.x * uv[0]; o[4 * h2 + 1] = a0.y * uv[1]; o[4 * h2 + 2] = a1.x * uv[2]; o[4 * h2 + 3] = a1.y * uv[3];
                    }
                    u32x4 w; w.x = pk2(o[0], o[1]); w.y = pk2(o[2], o[3]); w.z = pk2(o[4], o[5]); w.w = pk2(o[6], o[7]);
                    *(u32x4*)(ACT + (size_t)row * DFF + c0) = w;
                }
            }
            asm volatile("s_waitcnt vmcnt(0)" ::: "memory");
            __syncthreads();
        }
        { pg8::Gemm g{ACT, (const bf16_t*)(ws + W_DOWN), DFF, DFF, DFF, 0, 0, 128, 4}; pg8::EpiResid E{nullptr, nullptr, ws, (LAS float*)(ldsl + 133120)}; GSITE(8, pg8::gemm_phase(ldsl, g, E, wave)); }
        PSYNC(1);
    }
    {
        const int lane = (opq(tid) & 63);
        f32x4 gv[4];
#pragma unroll
        for (int j = 0; j < 2; ++j) { gv[2 * j] = *(const f32x4*)(a.in[I_FINAL] + 8 * lane + 512 * j); gv[2 * j + 1] = *(const f32x4*)(a.in[I_FINAL] + 8 * lane + 512 * j + 4); }
        for (int m = gw; m < M; m += NGW) {
            const float r = pg8::rstd_of(RSS, (size_t)m);
#pragma unroll
            for (int j = 0; j < 2; ++j) { const u32x4 v = *(const u32x4*)(XN + (size_t)m * D + 8 * lane + 512 * j);
                *(f32x4*)(H + (size_t)m * D + 8 * lane + 512 * j) = (f32x4){bflo(v.x), bfhi(v.x), bflo(v.y), bfhi(v.y)} * r * gv[2 * j];
                *(f32x4*)(H + (size_t)m * D + 8 * lane + 512 * j + 4) = (f32x4){bflo(v.z), bfhi(v.z), bflo(v.w), bfhi(v.w)} * r * gv[2 * j + 1]; }
        }
    }
#ifdef PROBE
    TICK(2);
    grid.sync();
    if (blockIdx.x == 0) {
        const unsigned v = cls[PROBE_RVR] / 1000u;
        for (unsigned i = tid; i < 16u * v; i += NT) H[i] += 0.05f;
        const unsigned long long t0 = __builtin_amdgcn_s_memrealtime(); const unsigned long long want = 2ull * cls[PROBE_DUR];
        while (__builtin_amdgcn_s_memrealtime() - t0 < want) __builtin_amdgcn_s_sleep(16);
    }
#endif
}

#undef tid
extern "C" void kernel_launch(void* const* d_in, const int* in_sizes, int n_in, void* d_out, int out_size, void* d_ws, size_t ws_size, hipStream_t stream) {
    static int grid = 0;
    if (grid == 0) {
        if (n_in != 29 || in_sizes[0] != M * D || out_size != M * D || ws_size < WS_END) { fprintf(stderr, "kernel_launch: unexpected shapes (n_in %d, ws %zu)\n", n_in, ws_size); grid = -1; return; }
        int dev = 0, cus = 0, per_cu = 0;
        (void)hipGetDevice(&dev);
        (void)hipDeviceGetAttribute(&cus, hipDeviceAttributeMultiprocessorCount, dev);
        (void)hipFuncSetAttribute((const void*)fwd, hipFuncAttributeMaxDynamicSharedMemorySize, LDS_BYTES);
        (void)hipOccupancyMaxActiveBlocksPerMultiprocessor(&per_cu, (const void*)fwd, NT, LDS_BYTES);
        if (per_cu < 1) per_cu = 1;
        grid = cus;
        (void)hipGetLastError();
    }
    if (grid < 0) return;
    if (hipMemsetAsync((char*)d_ws + T_CTL, 0, 16384, stream) != hipSuccess) { fprintf(stderr, "kernel_launch: memset failed\n"); return; }
    Args a{};
    for (int i = 0; i < 29; ++i) a.in[i] = (const float*)d_in[i];
    a.out = (float*)d_out; a.ws = (unsigned char*)d_ws;
    void* args[] = {&a};
    hipError_t e = hipLaunchCooperativeKernel((void*)fwd, dim3(grid), dim3(NT), args, LDS_BYTES, stream);
    if (e != hipSuccess) fprintf(stderr, "cooperative launch failed: %s\n", hipGetErrorString(e));
}
```

```cpp
#include <hip/hip_runtime.h>
#include <hip/hip_cooperative_groups.h>
#include <cstdio>
#include <cstdint>
namespace cg = cooperative_groups;

#define LAS __attribute__((address_space(3)))
typedef unsigned short bf16_t;
typedef short bf16x8 __attribute__((ext_vector_type(8)));
typedef short s16x4 __attribute__((ext_vector_type(4)));
typedef float f32x4 __attribute__((ext_vector_type(4)));
typedef float f32x2 __attribute__((ext_vector_type(2)));
typedef float f32x16 __attribute__((ext_vector_type(16)));
typedef unsigned u32x4 __attribute__((ext_vector_type(4)));
typedef unsigned u32x2 __attribute__((ext_vector_type(2)));

constexpr int NT = 512;
constexpr int LDS_BYTES = 147456;
constexpr int M = 32768, D = 1024, S = 2048, NB = 16, DFF = 2816;
constexpr float QSCALE = 0.125f * 1.4426950408889634f;

__device__ __forceinline__ unsigned f2bf(float f) { unsigned u = __builtin_bit_cast(unsigned, f); return (u + 0x7fffu + ((u >> 16) & 1u)) >> 16; }
typedef __bf16 bf16x2_t __attribute__((ext_vector_type(2)));
__device__ __forceinline__ unsigned pk2(float lo, float hi) { const f32x2 v = (f32x2){lo, hi}; const bf16x2_t b = __builtin_convertvector(v, bf16x2_t); return __builtin_bit_cast(unsigned, b); }
__device__ __forceinline__ float bf2f(unsigned short h) { return __builtin_bit_cast(float, (unsigned)h << 16); }
__device__ __forceinline__ float bflo(unsigned w) { return __builtin_bit_cast(float, w << 16); }
__device__ __forceinline__ float bfhi(unsigned w) { return __builtin_bit_cast(float, w & 0xffff0000u); }
__device__ __forceinline__ float wave_sum(float v) {
#pragma unroll
    for (int o = 1; o < 64; o <<= 1) v += __shfl_xor(v, o);
    return v;
}
__device__ __forceinline__ int opq(int v) { asm volatile("" : "+v"(v)); return v; }
__device__ __forceinline__ int lane_id() { int r; asm volatile("v_mbcnt_lo_u32_b32 %0, -1, 0\n\tv_mbcnt_hi_u32_b32 %0, -1, %0" : "=v"(r)); return r; }
__device__ __forceinline__ float swapmax(float v) { unsigned a = __builtin_bit_cast(unsigned, v), b = a; asm volatile("" : "+v"(b));
    const auto rr = __builtin_amdgcn_permlane32_swap(a, b, false, false);
    float r; asm volatile("v_max_f32_e32 %0, %1, %2" : "=v"(r) : "v"(rr[0]), "v"(rr[1])); return r; }
__device__ __forceinline__ float swapsum(float v) { unsigned a = __builtin_bit_cast(unsigned, v), b = a; asm volatile("" : "+v"(b));
    const auto rr = __builtin_amdgcn_permlane32_swap(a, b, false, false);
    float r; asm volatile("v_add_f32_e32 %0, %1, %2" : "=v"(r) : "v"(rr[0]), "v"(rr[1])); return r; }
__device__ __forceinline__ int crow(int r, int hi) { return (r & 3) + 8 * (r >> 2) + 4 * hi; }
__device__ __forceinline__ f32x2 gelu_pk(f32x2 v) {
    const f32x2 av = __builtin_elementwise_abs(v), d = av * 0.2316418882f + 1.0f;
    f32x2 t; t.x = __builtin_amdgcn_rcpf(d.x); t.y = __builtin_amdgcn_rcpf(d.y);
    f32x2 q = t * 0.5307027145f + (-0.7265760135f); q = q * t + 0.7107068705f; q = q * t + (-0.142248368f); q = q * t + 0.127414796f; q = q * t;
    const f32x2 s = (v * v) * (-0.72134752044f);
    f32x2 e; e.x = __builtin_amdgcn_exp2f(s.x); e.y = __builtin_amdgcn_exp2f(s.y);
    const f32x2 m = v * (q * e), r = v - m;
    f32x2 o; o.x = v.x < 0.f ? m.x : r.x; o.y = v.y < 0.f ? m.y : r.y; return o;
}

constexpr size_t MiB = 1u << 20;
constexpr size_t W_POOL = 0, W_DQK = 1 * MiB, W_DV = 5 * MiB, W_DO = 7 * MiB, W_LIN = 9 * MiB, W_LG = 13 * MiB, W_LOUT = 14 * MiB, W_XQKV = 16 * MiB, W_XO = 34 * MiB,
                 W_UP = 36 * MiB, W_DOWN = 47 * MiB, T_COS = 53 * MiB, T_SIN = 53 * MiB + 256 * 1024, T_RSTD = 53 * MiB + 512 * 1024, T_RSS = 54 * MiB, T_LSE = 56 * MiB, T_CTL = 58 * MiB,
                 WS_XN = 59 * MiB, WS_SCR = 123 * MiB, WS_MO = WS_SCR + 320 * MiB, T_AGG = WS_SCR + 128 * MiB, WS_END = 512 * MiB;
static_assert(WS_MO + 64 * MiB <= WS_END, "workspace map");

namespace pg8 {
constexpr int BM = 256, BK = 64, HALF = 128, HTB = HALF * BK * 2, STAGE_BYTES = 8 * HTB, NXCD = 8, WGM = 8;
__device__ __forceinline__ int lds_byte(int r, int c) { const int st = (r >> 4) * 2 + (c >> 5), rr = r & 15, cc = c & 31, ob = rr * 64 + cc * 2; return st * 1024 + (ob ^ (((ob >> 9) & 1) << 5)); }
__device__ __forceinline__ void stage_rc(int b, int& R, int& C) { const int st = b / 1024, sb = b % 1024, swz = sb ^ (((sb >> 9) & 1) << 5); R = (st >> 1) * 16 + swz / 64; C = (st & 1) * 32 + (swz % 64) / 2; }
__device__ __forceinline__ int perm32(int rho) { const int n = rho >> 4, i = rho & 15; return 8 * (i >> 2) + 4 * n + (i & 3); }

struct Unit { int pm, pn; };
struct Gemm { const bf16_t* A; const bf16_t* Bt; int K; int lda, ldb; int amode, bmode; int nM, nN; };
__device__ __forceinline__ size_t map_base(int mode, int p, int other, int ld) {
    if (mode == 1) { const int b = p >> 3, q = p & 7, r = q >> 1, mu = q & 1; return (size_t)(b * 2048 + 1024 * mu + r) * ld; }
    if (mode == 2) { const int b = p >> 3, rho = p & 7; return (size_t)(b * 2048 + 2 * rho) * ld; }
    if (mode == 3) return (size_t)p * 256 * ld + (size_t)other * 256;
    return (size_t)p * 256 * ld;
}
__device__ __forceinline__ int map_rs(int mode, int ld) { return mode == 1 ? 4 * ld : (mode == 2 ? 16 * ld : ld); }
__device__ __forceinline__ int map_hs(int mode, int ld) { return mode == 1 ? 512 * ld : (mode == 2 ? ld : 128 * ld); }

struct StaticOrder {
    int nM, nN, nwg, G, c;
    __device__ __forceinline__ void init(int nM_, int nN_, int G_, int c_) { nM = nM_; nN = nN_; nwg = nM * nN; G = G_; c = c_; }
    __device__ __forceinline__ bool next(int i, Unit& u) const {
        const long L = (long)i * G + c; if (L >= nwg) return false;
        int wgid = (int)L; { const int q = nwg / NXCD, r = nwg % NXCD, xcd = wgid % NXCD, off = wgid / NXCD; wgid = (xcd < r ? xcd * (q + 1) : r * (q + 1) + (xcd - r) * q) + off; }
        const int nig = WGM * nN, gid = wgid / nig, fm = gid * WGM, gsz = (nM - fm) < WGM ? (nM - fm) : WGM;
        u.pm = fm + ((wgid % nig) % gsz); u.pn = (wgid % nig) / gsz; return true;
    }
};

__device__ __forceinline__ unsigned cvt_pk_bf16(float lo, float hi) { unsigned r; asm volatile("v_cvt_pk_bf16_f32 %0, %1, %2" : "=v"(r) : "v"(lo), "v"(hi)); return r; }

__device__ __forceinline__ float rstd_of(const float* RSS, size_t row) {
    const f32x4 a = *(const f32x4*)(RSS + row * 4);
    return __builtin_amdgcn_rsqf(((a[0] + a[1]) + (a[2] + a[3])) * (1.0f / 1024.0f) + 1e-6f);
}
struct EpiPlain {
    static constexpr bool PERM = true;
    unsigned char* ws; size_t ooff; size_t ldc; int smode; int tmap;
    __device__ __forceinline__ void operator()(const f32x4 (&acc)[2][2][4][2], const Unit& u, int wr, int wc, int fr, int fq) const {
        const int row0 = u.pm * BM + wr * 64 + fr, col0 = u.pn * BM + wc * 32 + 8 * fq;
        bf16_t* O = (bf16_t*)(ws + ooff); const float* RSS = (const float*)(ws + T_RSS);
        float rsv[2][4];
#pragma unroll
        for (int ai = 0; ai < 2; ++ai)
#pragma unroll
            for (int m = 0; m < 4; ++m) rsv[ai][m] = (smode == 1) ? rstd_of(RSS, (size_t)(row0 + ai * HALF + m * 16)) : 1.f;
        f32x4 cs[2][2];
#pragma unroll
        for (int bj = 0; bj < 2; ++bj)
#pragma unroll
            for (int n = 0; n < 2; ++n)
#pragma unroll
                for (int e = 0; e < 4; ++e) { float v = 1.f;
                    if (smode == 2) { const int j = col0 + bj * HALF + 4 * n + e; const int jj = j & 2047; int t = jj; if (tmap == 1) t = 4 * (jj & 511) + (jj >> 9); else if (tmap == 2) t = 16 * (jj & 127) + (jj >> 7);
                        v = rstd_of(RSS, (size_t)(j - jj + t)); }
                    cs[bj][n][e] = v; }
#pragma unroll
        for (int ai = 0; ai < 2; ++ai)
#pragma unroll
            for (int m = 0; m < 4; ++m) { const int row = row0 + ai * HALF + m * 16; bf16_t* rowp = O + (size_t)row * ldc + col0;
                const float rs = rsv[ai][m];
#pragma unroll
                for (int bj = 0; bj < 2; ++bj) { const f32x4 v0 = acc[ai][bj][m][0] * cs[bj][0] * rs, v1 = acc[ai][bj][m][1] * cs[bj][1] * rs;
                    u32x4 w; w.x = cvt_pk_bf16(v0[0], v0[1]); w.y = cvt_pk_bf16(v0[2], v0[3]); w.z = cvt_pk_bf16(v1[0], v1[1]); w.w = cvt_pk_bf16(v1[2], v1[3]);
                    *(u32x4*)(rowp + bj * HALF) = w; } }
    }
};
struct EpiResid {
    static constexpr bool PERM = true;
    const float* xres; const float* cs; unsigned char* ws; LAS float* part;
    __device__ __forceinline__ void operator()(const f32x4 (&acc)[2][2][4][2], const Unit& u, int wr, int wc, int fr, int fq) const {
        const int col0 = u.pn * BM + wc * 32 + 8 * fq;
        bf16_t* XH = (bf16_t*)(ws + WS_XN); float* RSS = (float*)(ws + T_RSS);
        f32x4 sv[2][2];
#pragma unroll
        for (int bj = 0; bj < 2; ++bj)
#pragma unroll
            for (int n = 0; n < 2; ++n) sv[bj][n] = cs ? *(const f32x4*)(cs + col0 + bj * HALF + n * 4) : (f32x4){1.f, 1.f, 1.f, 1.f};
#pragma unroll
        for (int ai = 0; ai < 2; ++ai)
#pragma unroll
            for (int m = 0; m < 4; ++m) { const int row = u.pm * BM + ai * HALF + wr * 64 + m * 16 + fr; const size_t off = (size_t)row * D + col0; float ss = 0.f;
#pragma unroll
                for (int bj = 0; bj < 2; ++bj) {
                    f32x4 r0, r1;
                    if (xres) { r0 = *(const f32x4*)(xres + off + bj * HALF); r1 = *(const f32x4*)(xres + off + bj * HALF + 4); }
                    else { const u32x4 rv = *(const u32x4*)(XH + off + bj * HALF); r0 = (f32x4){bflo(rv.x), bfhi(rv.x), bflo(rv.y), bfhi(rv.y)}; r1 = (f32x4){bflo(rv.z), bfhi(rv.z), bflo(rv.w), bfhi(rv.w)}; }
                    const f32x4 o0 = r0 + acc[ai][bj][m][0] * sv[bj][0], o1 = r1 + acc[ai][bj][m][1] * sv[bj][1];
                    u32x4 w; w.x = cvt_pk_bf16(o0[0], o0[1]); w.y = cvt_pk_bf16(o0[2], o0[3]); w.z = cvt_pk_bf16(o1[0], o1[1]); w.w = cvt_pk_bf16(o1[2], o1[3]);
                    *(u32x4*)(XH + off + bj * HALF) = w;
                    ss += ((o0[0] * o0[0] + o0[1] * o0[1]) + (o0[2] * o0[2] + o0[3] * o0[3])) + ((o1[0] * o1[0] + o1[1] * o1[1]) + (o1[2] * o1[2] + o1[3] * o1[3])); }
                ss += __shfl_xor(ss, 16); ss += __shfl_xor(ss, 32);
                if (fq == 0) part[wc * 256 + ai * HALF + wr * 64 + m * 16 + fr] = ss; }
        asm volatile("s_waitcnt lgkmcnt(0)" ::: "memory"); __builtin_amdgcn_s_barrier(); asm volatile("" ::: "memory");
        const int tl = (wr * 4 + wc) * 64 + fq * 16 + fr;
        if (tl < 256) RSS[(size_t)(u.pm * BM + tl) * 4 + u.pn] = (part[tl] + part[256 + tl]) + (part[512 + tl] + part[768 + tl]);
    }
};
struct EpiRope {
    static constexpr bool PERM = true;
    unsigned char* ws; int mode; float qscale;
    __device__ __forceinline__ void operator()(const f32x4 (&acc)[2][2][4][2], const Unit& u, int wr, int wc, int fr, int fq) const {
        const int colt = u.pn * BM; const float sc = (colt < 1024) ? qscale : 1.f;
        bf16_t* O = (bf16_t*)(ws + WS_SCR); const float* cosT = (const float*)(ws + T_COS); const float* sinT = (const float*)(ws + T_SIN); const float* RSS = (const float*)(ws + T_RSS);
        float rsv[2][4];
#pragma unroll
        for (int ai = 0; ai < 2; ++ai)
#pragma unroll
            for (int m = 0; m < 4; ++m) { const int row = u.pm * BM + ai * HALF + wr * 64 + m * 16 + fr; const int jj = row & 2047;
                int t = jj; if (mode == 1) t = 4 * (jj & 511) + (jj >> 9); else if (mode == 2) t = 16 * (jj & 127) + (jj >> 7);
                rsv[ai][m] = rstd_of(RSS, (size_t)(row - jj + t)); }
#pragma unroll
        for (int ai = 0; ai < 2; ++ai)
#pragma unroll
            for (int m = 0; m < 4; ++m) { const int row = u.pm * BM + ai * HALF + wr * 64 + m * 16 + fr; const int jj = row & 2047;
                int t = jj; if (mode == 1) t = 4 * (jj & 511) + (jj >> 9); else if (mode == 2) t = 16 * (jj & 127) + (jj >> 7);
                const float scr_ = sc * rsv[ai][m];
#pragma unroll
                for (int bj = 0; bj < 2; ++bj) { const int col8 = colt + bj * HALF + wc * 32 + 8 * fq; const int hb = col8 & ~63, i4 = ((col8 & 63) >> 3) * 4;
                    const f32x4 c4 = *(const f32x4*)(cosT + t * 32 + i4), s4 = *(const f32x4*)(sinT + t * 32 + i4);
                    const f32x4 x1 = acc[ai][bj][m][0], x2 = acc[ai][bj][m][1];
                    const f32x4 o1 = (x1 * c4 - x2 * s4) * scr_, o2 = (x2 * c4 + x1 * s4) * scr_;
                    u32x2 w1, w2; w1.x = cvt_pk_bf16(o1[0], o1[1]); w1.y = cvt_pk_bf16(o1[2], o1[3]); w2.x = cvt_pk_bf16(o2[0], o2[1]); w2.y = cvt_pk_bf16(o2[2], o2[3]);
                    bf16_t* p = O + (size_t)row * 2048 + hb + i4;
                    *(u32x2*)p = w1; *(u32x2*)(p + 32) = w2; } }
    }
};


__device__ __forceinline__ float dpp_ror1(float v)  { return __builtin_bit_cast(float, __builtin_amdgcn_update_dpp(0, __builtin_bit_cast(int, v), 0x121, 0xF, 0xF, false)); }
__device__ __forceinline__ float dpp_ror15(float v) { return __builtin_bit_cast(float, __builtin_amdgcn_update_dpp(0, __builtin_bit_cast(int, v), 0x12F, 0xF, 0xF, false)); }
struct EpiFfnUp {
    static constexpr bool PERM = true;
    unsigned char* ws; const float* cw; const float* cb;
    __device__ __forceinline__ void operator()(const f32x4 (&acc)[2][2][4][2], const Unit& u, int wr, int wc, int fr, int fq) const {
        const int c0 = u.pn * 128 + wc * 32 + 8 * fq;
        bf16_t* act = (bf16_t*)(ws + WS_SCR); float* SB = (float*)(ws + WS_SCR + 176 * MiB); const float* RSS = (const float*)(ws + T_RSS);
        f32x4 w0[2], w1[2], w2[2], bb[2];
#pragma unroll
        for (int n = 0; n < 2; ++n) { w0[n] = *(const f32x4*)(cw + c0 + 4 * n); w1[n] = *(const f32x4*)(cw + DFF + c0 + 4 * n); w2[n] = *(const f32x4*)(cw + 2 * DFF + c0 + 4 * n); bb[n] = *(const f32x4*)(cb + c0 + 4 * n); }
        const bool f0 = (fr == 0), f15 = (fr == 15);
        float rsa[2][4];
#pragma unroll
        for (int ai = 0; ai < 2; ++ai)
#pragma unroll
            for (int m = 0; m < 4; ++m) rsa[ai][m] = rstd_of(RSS, (size_t)(u.pm * BM + ai * HALF + wr * 64 + m * 16 + fr));
#pragma unroll
        for (int ai = 0; ai < 2; ++ai) {
            const int G = 4 * u.pm + 2 * ai + wr;
            float rsv[4];
#pragma unroll
            for (int m = 0; m < 4; ++m) rsv[m] = rsa[ai][m];
#pragma unroll
            for (int m = 0; m < 4; ++m) {
                const int row = u.pm * BM + ai * HALF + wr * 64 + m * 16 + fr;
                f32x4 gc[2], gs[2];
#pragma unroll
                for (int n = 0; n < 2; ++n)
#pragma unroll
                    for (int e = 0; e < 4; ++e) {
                        const float gm = acc[ai][0][m][n][e] * rsv[m];
                        const float gprev = (m > 0) ? acc[ai][0][m > 0 ? m - 1 : 0][n][e] * rsv[m > 0 ? m - 1 : 0] : 0.f, gnext = (m < 3) ? acc[ai][0][m < 3 ? m + 1 : 3][n][e] * rsv[m < 3 ? m + 1 : 3] : 0.f;
                        const float pv = dpp_ror1(f15 ? gprev : gm), nv = dpp_ror15(f0 ? gnext : gm);
                        gs[n][e] = gm;
                        gc[n][e] = bb[n][e] + w0[n][e] * pv + w1[n][e] * gm + w2[n][e] * nv;
                    }
                const bool isfirst = (m == 0) && f0, islast = (m == 3) && f15;
                if (isfirst || islast) {
                    float* sp = SB + ((size_t)(islast ? 1 : 0) * 512 + G) * DFF + c0;
#pragma unroll
                    for (int n = 0; n < 2; ++n) { *(f32x4*)(sp + 4 * n) = gc[n]; *(f32x4*)(sp + (size_t)2 * 512 * DFF + 4 * n) = gs[n]; *(f32x4*)(sp + (size_t)4 * 512 * DFF + 4 * n) = acc[ai][1][m][n] * rsv[m]; }
                } else {
                    const f32x2 a0 = gelu_pk((f32x2){gc[0][0], gc[0][1]}), a1 = gelu_pk((f32x2){gc[0][2], gc[0][3]}), a2 = gelu_pk((f32x2){gc[1][0], gc[1][1]}), a3 = gelu_pk((f32x2){gc[1][2], gc[1][3]});
                    const f32x4 u0 = acc[ai][1][m][0] * rsv[m], u1 = acc[ai][1][m][1] * rsv[m];
                    u32x4 w; w.x = cvt_pk_bf16(a0.x * u0[0], a0.y * u0[1]); w.y = cvt_pk_bf16(a1.x * u0[2], a1.y * u0[3]); w.z = cvt_pk_bf16(a2.x * u1[0], a2.y * u1[1]); w.w = cvt_pk_bf16(a3.x * u1[2], a3.y * u1[3]);
                    *(u32x4*)(act + (size_t)row * DFF + c0) = w;
                }
            }
        }
    }
};

template <class Epi, bool ALIGN_EPI = true>
__device__ __forceinline__ void gemm_phase(LAS unsigned char* lds, const Gemm g, const Epi& E, int wv) {
    const int wid = wv, lane = opq(lane_id()), tid = (wid << 6) | lane, wr = wid >> 2, wc = wid & 3, fr = lane & 15, fq = lane >> 4;
    StaticOrder S; S.init(g.nM, g.nN, (int)gridDim.x, (int)blockIdx.x);
    const int K = g.K, nt = K / BK;
    const int a_rs = map_rs(g.amode, g.lda), b_rs = map_rs(g.bmode, g.ldb);
    unsigned voffA[2], voffB[2];
#pragma unroll
    for (int i = 0; i < 2; ++i) { int R, C; stage_rc(tid * 16 + i * 8192, R, C); const int Rb = Epi::PERM ? ((R & ~31) + perm32(R & 31)) : R;
        voffA[i] = (unsigned)(R * a_rs + C) * 2u; voffB[i] = (unsigned)(Rb * b_rs + C) * 2u; }
    const size_t kstep = (size_t)(BK * 2);
    const size_t hstepA = (size_t)map_hs(g.amode, g.lda) * 2, hstepB = (size_t)map_hs(g.bmode, g.ldb) * 2;
    const unsigned ldsw = (unsigned)wid * 1024u;
    const int aoff = lds_byte(wr * 64 + fr, fq * 8), boff = lds_byte(wc * 32 + fr, fq * 8);
#define PG8_SA(b, h) (((b) * 2 + (h)) * HTB)
#define PG8_SB(b, h) ((4 + (b) * 2 + (h)) * HTB)
#define PG8_STAGE(bufoff, gbase, voff) do { _Pragma("unroll") for (int _i = 0; _i < 2; ++_i) \
        __builtin_amdgcn_global_load_lds((const unsigned*)((const char*)(gbase) + (voff)[_i]), (LAS unsigned*)(lds + (bufoff) + ldsw + _i * 8192), 16, 0, 0); } while (0)
#define PG8_LDA(dst, b, h) do { _Pragma("unroll") for (int m = 0; m < 4; ++m) _Pragma("unroll") for (int k = 0; k < 2; ++k) dst[m][k] = *(const LAS bf16x8*)(lds + PG8_SA(b, h) + aoff + m * 2048 + k * 1024); } while (0)
#define PG8_LDB(dst, b, h) do { _Pragma("unroll") for (int n = 0; n < 2; ++n) _Pragma("unroll") for (int k = 0; k < 2; ++k) dst[n][k] = *(const LAS bf16x8*)(lds + PG8_SB(b, h) + boff + n * 2048 + k * 1024); } while (0)
#define PG8_MMA(ai, bj, At, Bt) do { __builtin_amdgcn_s_setprio(1); _Pragma("unroll") for (int m = 0; m < 4; ++m) _Pragma("unroll") for (int n = 0; n < 2; ++n) _Pragma("unroll") for (int k = 0; k < 2; ++k) \
        acc[ai][bj][m][n] = __builtin_amdgcn_mfma_f32_16x16x32_bf16(Bt[n][k], At[m][k], acc[ai][bj][m][n], 0, 0, 0); __builtin_amdgcn_s_setprio(0); } while (0)
#define PG8_WAIT_V(n) asm volatile("s_waitcnt vmcnt(" #n ")" ::: "memory")
#define PG8_WAIT_L(n) asm volatile("s_waitcnt lgkmcnt(" #n ")" ::: "memory")
#define PG8_BAR __builtin_amdgcn_s_barrier()
#define PG8_SCHED __builtin_amdgcn_sched_barrier(0)
    Unit cur, nxt; int ui = 0;
    if (!S.next(0, cur)) return;
    f32x4 acc[2][2][4][2];
#pragma unroll
    for (int a = 0; a < 2; ++a)
#pragma unroll
        for (int b = 0; b < 2; ++b)
#pragma unroll
            for (int m = 0; m < 4; ++m)
#pragma unroll
                for (int n = 0; n < 2; ++n) acc[a][b][m][n] = (f32x4){0.f, 0.f, 0.f, 0.f};
    bf16x8 At[4][2], B0[2][2], B1[2][2];
    const char* cA = (const char*)g.A + map_base(g.amode, cur.pm, cur.pn, g.lda) * 2; const char* cB = (const char*)g.Bt + map_base(g.bmode, cur.pn, cur.pm, g.ldb) * 2;
    PG8_STAGE(PG8_SB(0, 0), cB, voffB); PG8_STAGE(PG8_SB(0, 1), cB + hstepB, voffB); PG8_STAGE(PG8_SA(0, 0), cA, voffA); PG8_STAGE(PG8_SA(0, 1), cA + hstepA, voffA);
    if (wr == 1) PG8_BAR;
    PG8_WAIT_V(2); PG8_BAR;
    PG8_STAGE(PG8_SB(1, 0), cB + kstep, voffB); PG8_STAGE(PG8_SA(1, 0), cA + kstep, voffA); PG8_STAGE(PG8_SB(1, 1), cB + hstepB + kstep, voffB);
    PG8_WAIT_V(6); PG8_BAR;
    for (;;) {
        const bool has_next = S.next(ui + 1, nxt);
        const char* nA = has_next ? (const char*)g.A + map_base(g.amode, nxt.pm, nxt.pn, g.lda) * 2 : cA; const char* nB = has_next ? (const char*)g.Bt + map_base(g.bmode, nxt.pn, nxt.pm, g.ldb) * 2 : cB;
        for (int t = 0; t < nt; t += 2) {
            const bool last = (t == nt - 2);
            const char* a1 = cA + (size_t)(t + 1) * kstep;
            const char* a2 = last ? nA : cA + (size_t)(t + 2) * kstep; const char* b2 = last ? nB : cB + (size_t)(t + 2) * kstep;
            const char* a3 = a2 + kstep; const char* b3 = b2 + kstep;
            PG8_LDB(B0, 0, 0); PG8_LDB(B1, 0, 1); PG8_SCHED; PG8_LDA(At, 0, 0); PG8_STAGE(PG8_SA(1, 1), a1 + hstepA, voffA);
            PG8_WAIT_V(8); PG8_WAIT_L(0); PG8_BAR; PG8_MMA(0, 0, At, B0); PG8_MMA(0, 1, At, B1); PG8_BAR; PG8_SCHED;
            PG8_LDA(At, 0, 1); PG8_STAGE(PG8_SB(0, 0), b2, voffB); PG8_STAGE(PG8_SB(0, 1), b2 + hstepB, voffB); PG8_STAGE(PG8_SA(0, 0), a2, voffA);
            PG8_WAIT_V(8); PG8_WAIT_L(0); PG8_BAR; PG8_MMA(1, 0, At, B0); PG8_MMA(1, 1, At, B1); PG8_BAR; PG8_SCHED;
            PG8_LDB(B0, 1, 0); PG8_LDB(B1, 1, 1); PG8_SCHED; PG8_LDA(At, 1, 0); PG8_STAGE(PG8_SA(0, 1), a2 + hstepA, voffA);
            PG8_WAIT_V(8); PG8_WAIT_L(0); PG8_BAR; PG8_MMA(0, 0, At, B0); PG8_MMA(0, 1, At, B1); PG8_BAR; PG8_SCHED;
            PG8_LDA(At, 1, 1); PG8_STAGE(PG8_SB(1, 0), b3, voffB); PG8_STAGE(PG8_SB(1, 1), b3 + hstepB, voffB); PG8_STAGE(PG8_SA(1, 0), a3, voffA);
            PG8_WAIT_V(8); PG8_WAIT_L(0); PG8_BAR; PG8_MMA(1, 0, At, B0); PG8_MMA(1, 1, At, B1); PG8_BAR; PG8_SCHED;
        }
        if constexpr (ALIGN_EPI) { if (wr == 0) PG8_BAR; }
        E(acc, cur, wr, wc, fr, fq);
        if (!has_next) break;
#pragma unroll
        for (int a = 0; a < 2; ++a)
#pragma unroll
            for (int b = 0; b < 2; ++b)
#pragma unroll
                for (int m = 0; m < 4; ++m)
#pragma unroll
                    for (int n = 0; n < 2; ++n) acc[a][b][m][n] = (f32x4){0.f, 0.f, 0.f, 0.f};
        cur = nxt; cA = nA; cB = nB; ++ui;
        if constexpr (ALIGN_EPI) { if (wr == 1) PG8_BAR; }
    }
    PG8_WAIT_V(0);
    if constexpr (!ALIGN_EPI) { if (wr == 0) PG8_BAR; }
    PG8_BAR;
#undef PG8_SA
#undef PG8_SB
#undef PG8_STAGE
#undef PG8_LDA
#undef PG8_LDB
#undef PG8_MMA
#undef PG8_WAIT_V
#undef PG8_WAIT_L
#undef PG8_BAR
#undef PG8_SCHED
}
}

struct Args { const float* in[29]; float* out; unsigned char* ws; };
enum { I_X = 0, I_POS, I_MIXNORM, I_POOLW, I_POOLS, I_DQKV, I_LQ1, I_LK1, I_LQ2, I_LK2, I_SUBLN, I_DWO, I_LWIN, I_LCW, I_LCB, I_LWA, I_LBA, I_LWX, I_LBX, I_LLAM, I_LWOUT,
       I_XQKV, I_XWO, I_FNORM, I_FUP, I_FCW, I_FCB, I_FDOWN, I_FINAL };

__device__ __forceinline__ int ropeperm(int n) { const int d = n & 63; const int p = d < 32 ? 8 * (d >> 2) + (d & 3) : 8 * ((d - 32) >> 2) + 4 + (d & 3); return (n & ~63) + p; }
__device__ __forceinline__ void transpose_mat(const float* W, int K, int N, int ldn, int c0, bf16_t* WT, int rmode, LAS float* scr, int gw, int NGW, int lane_in, const float* kg = nullptr) {
    const int lane = opq(lane_in) & 63;
    const int nblk = N / 32, items = (K / 64) * nblk;
    for (int item = gw; item < items; item += NGW) {
        const int kb = item / nblk, nb = item % nblk, k0 = 64 * kb, n0 = 32 * nb;
#pragma unroll 16
        for (int i = 0; i < 32; ++i) { const int kk = 2 * i + (lane >> 5); scr[kk * 33 + (lane & 31)] = W[(size_t)(k0 + kk) * ldn + c0 + n0 + (lane & 31)] * (kg ? kg[k0 + kk] : 1.0f); }
        asm volatile("s_waitcnt lgkmcnt(0)" ::: "memory");
        const int c = lane & 7;
#pragma unroll
        for (int j = 0; j < 4; ++j) { const int n = (lane >> 3) + 8 * j; const LAS float* s = scr + (8 * c) * 33 + n;
            u32x4 o; o.x = pk2(s[0 * 33], s[1 * 33]); o.y = pk2(s[2 * 33], s[3 * 33]); o.z = pk2(s[4 * 33], s[5 * 33]); o.w = pk2(s[6 * 33], s[7 * 33]);
            int dn = n0 + n;
            if (rmode == 1) dn = ropeperm(dn);
            else if (rmode == 2) { const int gq = dn / 3072, nl = dn % 3072; dn = gq * 3072 + (nl < 2048 ? ropeperm(nl) : nl); }
            else if (rmode == 3) { const int isu = dn >= DFF ? 1 : 0, nl = dn - isu * DFF; dn = 256 * (nl >> 7) + 128 * isu + (nl & 127); }
            *(u32x4*)(WT + (size_t)dn * K + k0 + 8 * c) = o; }
        asm volatile("s_waitcnt lgkmcnt(0)" ::: "memory");
    }
}
__device__ __forceinline__ void convert_ffn(const Args& a, int layer, LAS float* scr, int gw, int NGW, int lane) {
    transpose_mat(a.in[I_FUP] + (size_t)layer * D * 2 * DFF, D, 2 * DFF, 2 * DFF, 0, (bf16_t*)(a.ws + W_UP), 3, scr, gw, NGW, lane, a.in[I_FNORM] + layer * D);
    transpose_mat(a.in[I_FDOWN] + (size_t)layer * DFF * D, DFF, D, D, 0, (bf16_t*)(a.ws + W_DOWN), 0, scr, gw, NGW, lane);
}
__device__ __forceinline__ void norm_rows(const float* src, const float* gain, bf16_t* dst, int gw, int NGW, int lane_in) {
    const int lane = opq(lane_in) & 63;
    f32x4 gv[4];
#pragma unroll
    for (int j = 0; j < 4; ++j) gv[j] = ((const f32x4*)gain)[lane + 64 * j];
    for (int m = gw; m < M; m += NGW) {
        const f32x4* xr = (const f32x4*)(src + (size_t)m * D) + lane;
        f32x4 v[4]; float s = 0.f;
#pragma unroll
        for (int j = 0; j < 4; ++j) { v[j] = xr[64 * j]; s += (v[j].x * v[j].x + v[j].y * v[j].y) + (v[j].z * v[j].z + v[j].w * v[j].w); }
        const float r = 1.0f / sqrtf(wave_sum(s) * (1.f / D) + 1e-6f);
        u32x2* o8 = (u32x2*)(dst + (size_t)m * D) + lane;
#pragma unroll
        for (int j = 0; j < 4; ++j) { u32x2 w; w.x = pk2(v[j].x * r * gv[j].x, v[j].y * r * gv[j].y); w.y = pk2(v[j].z * r * gv[j].z, v[j].w * r * gv[j].w); o8[64 * j] = w; }
    }
}

constexpr int DA_KP = 272, DA_VP = 144, DA_KOFF = 0, DA_VOFF = 64 * DA_KP, DA_BUF = 64 * DA_KP + 128 * DA_VP, DA_XOFF = 0;

__device__ __forceinline__ void da_qk(f32x16 (&st)[2], const LAS unsigned char* kb, const bf16x8 (&qf)[4]) {
#pragma unroll
    for (int t2 = 0; t2 < 2; ++t2) {
        bf16x8 kf[4];
#pragma unroll
        for (int ks = 0; ks < 4; ++ks) kf[ks] = *(const LAS bf16x8*)(kb + t2 * 32 * DA_KP + ks * 32);
        __builtin_amdgcn_sched_barrier(0);
#pragma unroll
        for (int r = 0; r < 16; ++r) st[t2][r] = 0.f;
#pragma unroll
        for (int ks = 0; ks < 4; ++ks) st[t2] = __builtin_amdgcn_mfma_f32_32x32x16_bf16(kf[ks], qf[ks], st[t2], 0, 0, 0);
    }
}
__device__ __forceinline__ void da_softmax(f32x16 (&st)[2], float& mrun, float& lrun, f32x16 (&ot)[4], bool first, bf16x8 (&pb)[4]) {
    float a = fmaxf(fmaxf(st[0][0], st[0][1]), st[0][2]), b2 = fmaxf(fmaxf(st[1][0], st[1][1]), st[1][2]);
    a = fmaxf(a, st[0][3]); b2 = fmaxf(b2, st[1][3]);
#pragma unroll
    for (int r = 4; r < 16; r += 2) { a = fmaxf(fmaxf(a, st[0][r]), st[0][r + 1]); b2 = fmaxf(fmaxf(b2, st[1][r]), st[1][r + 1]); }
    float mx = fmaxf(a, b2);
    mx = swapmax(mx);
    if (first || __any(mx > mrun + 8.0f)) {
        const float mnew = first ? mx : fmaxf(mx, mrun);
        const float alpha = first ? 0.f : __builtin_amdgcn_exp2f(mrun - mnew);
        lrun *= alpha;
#pragma unroll
        for (int dt = 0; dt < 4; ++dt) ot[dt] = ot[dt] * alpha;
        mrun = mnew;
    }
    float acc0 = 0.f, acc1 = 0.f, acc2 = 0.f, acc3 = 0.f;
#pragma unroll
    for (int t2 = 0; t2 < 2; ++t2)
#pragma unroll
        for (int r = 0; r < 16; r += 4) {
            const float p0 = __builtin_amdgcn_exp2f(st[t2][r] - mrun), p1 = __builtin_amdgcn_exp2f(st[t2][r + 1] - mrun), p2 = __builtin_amdgcn_exp2f(st[t2][r + 2] - mrun), p3 = __builtin_amdgcn_exp2f(st[t2][r + 3] - mrun);
            st[t2][r] = p0; st[t2][r + 1] = p1; st[t2][r + 2] = p2; st[t2][r + 3] = p3;
            acc0 += p0; acc1 += p1; acc2 += p2; acc3 += p3; }
    lrun += (acc0 + acc1) + (acc2 + acc3);
#pragma unroll
    for (int s = 0; s < 4; ++s) { const int t2 = s >> 1, r0 = 8 * (s & 1);
        u32x4 w; w.x = pk2(st[t2][r0], st[t2][r0 + 1]); w.y = pk2(st[t2][r0 + 2], st[t2][r0 + 3]); w.z = pk2(st[t2][r0 + 4], st[t2][r0 + 5]); w.w = pk2(st[t2][r0 + 6], st[t2][r0 + 7]);
        pb[s] = __builtin_bit_cast(bf16x8, w); }
}
__device__ __forceinline__ void da_pv(f32x16 (&ot)[4], const LAS unsigned char* vb, const bf16x8 (&pb)[4]) {
    bf16x8 vn[4];
#pragma unroll
    for (int s = 0; s < 4; ++s) vn[s] = *(const LAS bf16x8*)(vb + 32 * s);
#pragma unroll
    for (int dt = 0; dt < 4; ++dt) {
        bf16x8 vf[4];
#pragma unroll
        for (int s = 0; s < 4; ++s) vf[s] = vn[s];
        if (dt < 3) {
#pragma unroll
            for (int s = 0; s < 4; ++s) vn[s] = *(const LAS bf16x8*)(vb + (dt + 1) * 32 * DA_VP + 32 * s);
        }
        __builtin_amdgcn_sched_barrier(0);
#pragma unroll
        for (int s = 0; s < 4; ++s) ot[dt] = __builtin_amdgcn_mfma_f32_32x32x16_bf16(vf[s], pb[s], ot[dt], 0, 0, 0);
        __builtin_amdgcn_sched_barrier(0);
    }
}
__device__ __forceinline__ void diff_attn_phase(unsigned char* ldsg, const bf16_t* QK, const bf16_t* Vt, bf16_t* O, float lam, float lam_init, const float* subln, int wv) {
    LAS unsigned char* lds = (LAS unsigned char*)ldsg;
    const int wave = wv, lane = opq(lane_id()), tid = (wave << 6) | lane, qg = wave & 3, c = wave >> 2, l31 = lane & 31, hi = lane >> 5;
    const int vb = ((gridDim.x & 7) == 0) ? (int)((blockIdx.x & 7) * (gridDim.x >> 3) + (blockIdx.x >> 3)) : (int)blockIdx.x;
    for (int unit = vb; unit < 2048; unit += gridDim.x) {
        const int b = unit >> 7, hh = (unit >> 4) & 7, qb = unit & 15;
        const size_t rowb = (size_t)b * S;
        const bf16_t* qp = QK + (rowb + qb * 128 + qg * 32 + l31) * 2048 + 128 * hh + 64 * c + 8 * hi;
        bf16x8 qf[4];
#pragma unroll
        for (int ks = 0; ks < 4; ++ks) qf[ks] = *(const bf16x8*)(qp + 16 * ks);
        const bf16_t* kg = QK + rowb * 2048 + 1024 + 128 * hh;
        const bf16_t* vg = Vt + (size_t)(128 * hh) * M + rowb;
        unsigned ksrc[2], vsrc[2]; int kdst[2], vdst[2];
#pragma unroll
        for (int i = 0; i < 2; ++i) { const int id = tid + 512 * i;
            ksrc[i] = (unsigned)((id >> 4) * 2048 + (id & 15) * 8); kdst[i] = DA_KOFF + (id >> 4) * DA_KP + (id & 15) * 16;
            vsrc[i] = (unsigned)((id >> 3) * M + (id & 7) * 8);     vdst[i] = DA_VOFF + (id >> 3) * DA_VP + ((id & 7) >> 1) * 32 + (id & 1) * 8; }
        u32x4 kr[2][2], vr[2][2];
#pragma unroll
        for (int tt = 0; tt < 2; ++tt)
#pragma unroll
            for (int i = 0; i < 2; ++i) { kr[tt][i] = *(const u32x4*)(kg + (size_t)tt * 64 * 2048 + ksrc[i]); vr[tt][i] = *(const u32x4*)(vg + tt * 64 + vsrc[i]); }
        __syncthreads();
#pragma unroll
        for (int tt = 0; tt < 2; ++tt)
#pragma unroll
            for (int i = 0; i < 2; ++i) { *(LAS u32x4*)(lds + tt * DA_BUF + kdst[i]) = kr[tt][i]; *(LAS u32x2*)(lds + tt * DA_BUF + vdst[i]) = (u32x2){vr[tt][i].x, vr[tt][i].y}; *(LAS u32x2*)(lds + tt * DA_BUF + vdst[i] + 16) = (u32x2){vr[tt][i].z, vr[tt][i].w}; }
        __syncthreads();
        f32x16 ot[4];
#pragma unroll
        for (int dt = 0; dt < 4; ++dt)
#pragma unroll
            for (int r = 0; r < 16; ++r) ot[dt][r] = 0.f;
        float mrun = 0.f, lrun = 0.f;
        const LAS unsigned char* kbase = lds + DA_KOFF + l31 * DA_KP + (64 * c + 8 * hi) * 2;
        const LAS unsigned char* vbase = lds + DA_VOFF + l31 * DA_VP + 16 * hi;
        for (int kp = 0; kp < 16; ++kp) {
            if (kp + 1 < 16) {
#pragma unroll
                for (int tt = 0; tt < 2; ++tt)
#pragma unroll
                    for (int i = 0; i < 2; ++i) { kr[tt][i] = *(const u32x4*)(kg + (size_t)(2 * kp + 2 + tt) * 64 * 2048 + ksrc[i]); vr[tt][i] = *(const u32x4*)(vg + (2 * kp + 2 + tt) * 64 + vsrc[i]); }
            }
            f32x16 sa[2];
            bf16x8 pa[4], pb[4];
            da_qk(sa, kbase, qf);
            da_softmax(sa, mrun, lrun, ot, kp == 0, pa);
            __builtin_amdgcn_sched_barrier(0);
            da_qk(sa, kbase + DA_BUF, qf);
            da_pv(ot, vbase, pa);
            __builtin_amdgcn_sched_barrier(0);
            da_softmax(sa, mrun, lrun, ot, false, pb);
            da_pv(ot, vbase + DA_BUF, pb);
            __syncthreads();
            if (kp + 1 < 16) {
#pragma unroll
                for (int tt = 0; tt < 2; ++tt)
#pragma unroll
                    for (int i = 0; i < 2; ++i) { *(LAS u32x4*)(lds + tt * DA_BUF + kdst[i]) = kr[tt][i]; *(LAS u32x2*)(lds + tt * DA_BUF + vdst[i]) = (u32x2){vr[tt][i].x, vr[tt][i].y}; *(LAS u32x2*)(lds + tt * DA_BUF + vdst[i] + 16) = (u32x2){vr[tt][i].z, vr[tt][i].w}; }
            }
            __syncthreads();
        }
        const float ltot = swapsum(lrun);
        const float inv = __builtin_amdgcn_rcpf(ltot);
        LAS float* X = (LAS float*)(lds + DA_XOFF) + (qg * 64) * 64 + lane;
        if (c == 1) {
#pragma unroll
            for (int dt = 0; dt < 4; ++dt)
#pragma unroll
                for (int r = 0; r < 16; ++r) X[(dt * 16 + r) * 64] = ot[dt][r] * inv;
        }
        __syncthreads();
        if (c == 0) {
            float ss = 0.f;
#pragma unroll
            for (int dt = 0; dt < 4; ++dt)
#pragma unroll
                for (int r = 0; r < 16; ++r) { const float o = ot[dt][r] * inv - lam * X[(dt * 16 + r) * 64]; ot[dt][r] = o; ss += o * o; }
            ss = swapsum(ss);
            const float rs = __builtin_amdgcn_rsqf(ss * (1.f / 128.f) + 1e-5f) * (1.0f - lam_init);
            bf16_t* op = O + (rowb + qb * 128 + qg * 32 + l31) * D + 128 * hh;
#pragma unroll
            for (int dt = 0; dt < 4; ++dt)
#pragma unroll
                for (int g4 = 0; g4 < 4; ++g4) { const int d0 = 32 * dt + 8 * g4 + 4 * hi; const f32x4 sg = *(const f32x4*)(subln + d0);
                    u32x2 w; w.x = pk2(ot[dt][4 * g4] * rs * sg[0], ot[dt][4 * g4 + 1] * rs * sg[1]); w.y = pk2(ot[dt][4 * g4 + 2] * rs * sg[2], ot[dt][4 * g4 + 3] * rs * sg[3]);
                    *(u32x2*)(op + d0) = w; }
        }
    }
    __syncthreads();
}

constexpr int DL_KP = 144, DL_VP = 784, DL_VOFF = 384 * DL_KP;
__device__ __forceinline__ void dil_attn_phase(int gi, unsigned char* ldsg, const bf16_t* QKg, const bf16_t* Vtg, float* Oacc, float* LSE, bf16_t* Ofin, int wv) {
    LAS unsigned char* lds = (LAS unsigned char*)ldsg;
    const int wave = wv, lane = opq(lane_id()), tid = (wave << 6) | lane, l31 = lane & 31, hi = lane >> 5;
    const int lgn = (gi == 0) ? 11 : (gi == 1 ? 9 : 7), lgd = 11 - lgn, n = 1 << lgn;
    const int vb = ((gridDim.x & 7) == 0) ? (int)((blockIdx.x & 7) * (gridDim.x >> 3) + (blockIdx.x >> 3)) : (int)blockIdx.x;
    u32x4 vst[6];
#define DL_LOADV(bi_) do { const int i8_ = (bi_) & 7, head_ = ((bi_) >> 3) & 15, b_ = (bi_) >> 7; const int w0_ = 256 * i8_ - 64; \
        _Pragma("unroll") for (int i = 0; i < 6; ++i) { const int id = tid + 512 * i; const int d = id / 48, c16 = id - 48 * d; const int jw = min(max(w0_ + 8 * c16, 0), S - 8); \
            vst[i] = *(const u32x4*)(Vtg + (size_t)(head_ * 64 + d) * M + (size_t)b_ * S + jw); } } while (0)
    if (vb < 2048) DL_LOADV(vb);
    for (int bi = vb; bi < 2048; bi += gridDim.x) {
        const int i8 = bi & 7, head = (bi >> 3) & 15, b = bi >> 7;
        const int J0 = 256 * i8, w0 = J0 - 64;
        const size_t rb = (size_t)b * S;
        __syncthreads();
#pragma unroll
        for (int i = 0; i < 6; ++i) { const int id = tid + 512 * i; const int d = id / 48, c16 = id - 48 * d;
            LAS unsigned char* vd = lds + DL_VOFF + d * DL_VP + (c16 >> 1) * 32 + (c16 & 1) * 8;
            *(LAS u32x2*)vd = (u32x2){vst[i].x, vst[i].y}; *(LAS u32x2*)(vd + 16) = (u32x2){vst[i].z, vst[i].w}; }
        if (bi + (int)gridDim.x < 2048) DL_LOADV(bi + (int)gridDim.x);
        const int jq0 = J0 + 32 * wave, jq = jq0 + l31;
        const int r = jq0 >> lgn, mq = jq & (n - 1);
        const int tq = (mq << lgd) + r;
        const size_t row = rb + tq;
        f32x4 oa[2][4]; float la = 0.f;
#pragma unroll
        for (int dt = 0; dt < 2; ++dt)
#pragma unroll
            for (int g4 = 0; g4 < 4; ++g4) oa[dt][g4] = (f32x4){0.f, 0.f, 0.f, 0.f};
        if (gi > 0) { la = LSE[row * 16 + head];
#pragma unroll
            for (int dt = 0; dt < 2; ++dt)
#pragma unroll
                for (int g4 = 0; g4 < 4; ++g4) oa[dt][g4] = *(const f32x4*)(Oacc + row * D + head * 64 + 32 * dt + 8 * g4 + 4 * hi); }
        const bf16_t* qp = QKg + (rb + jq) * 2048 + head * 64 + 8 * hi;
        bf16x8 qf[4];
#pragma unroll
        for (int ks = 0; ks < 4; ++ks) qf[ks] = *(const bf16x8*)(qp + 16 * ks);
#define DL_LOADK(ti_, dst) do { const int jk0_ = w0 + 32 * wave + 32 * (ti_); const int jkc_ = min(max(jk0_, 0), S - 32); \
            const bf16_t* kpg_ = QKg + (rb + jkc_ + l31) * 2048 + 1024 + head * 64 + 8 * hi; \
            _Pragma("unroll") for (int ks = 0; ks < 4; ++ks) dst[ks] = *(const bf16x8*)(kpg_ + 16 * ks); } while (0)
#define DL_QK(ti_, src) do { const int jk0_ = w0 + 32 * wave + 32 * (ti_); const bool inr_ = (jk0_ >= 0) && (jk0_ < S) && ((jk0_ >> lgn) == r); \
            _Pragma("unroll") for (int rr = 0; rr < 16; ++rr) st[ti_][rr] = 0.f; \
            _Pragma("unroll") for (int ks = 0; ks < 4; ++ks) st[ti_] = __builtin_amdgcn_mfma_f32_32x32x16_bf16(src[ks], qf[ks], st[ti_], 0, 0, 0); \
            _Pragma("unroll") for (int rr = 0; rr < 16; ++rr) { bool ok = inr_; if ((ti_) == 0) ok = ok && (crow(rr, hi) >= l31); if ((ti_) == 4) ok = ok && (crow(rr, hi) <= l31); if (!ok) st[ti_][rr] = -1e30f; } } while (0)
        bf16x8 kA[4], kB[4], kC[4];
        DL_LOADK(0, kA); DL_LOADK(1, kB); DL_LOADK(2, kC);
        __syncthreads();
        f32x16 st[5];
        DL_QK(0, kA); __builtin_amdgcn_sched_barrier(0); DL_LOADK(3, kA); __builtin_amdgcn_sched_barrier(0);
        DL_QK(1, kB); __builtin_amdgcn_sched_barrier(0); DL_LOADK(4, kB); __builtin_amdgcn_sched_barrier(0);
        DL_QK(2, kC); DL_QK(3, kA); DL_QK(4, kB);
#undef DL_LOADK
#undef DL_QK
        float mx = st[2][0];
#pragma unroll
        for (int ti = 0; ti < 5; ++ti)
#pragma unroll
            for (int rr = 0; rr < 16; ++rr) mx = fmaxf(mx, st[ti][rr]);
        mx = swapmax(mx);
        float ps = 0.f;
#pragma unroll
        for (int ti = 0; ti < 5; ++ti)
#pragma unroll
            for (int rr = 0; rr < 16; ++rr) { const float p = __builtin_amdgcn_exp2f(st[ti][rr] - mx); st[ti][rr] = p; ps += p; }
        f32x16 ot[2];
#pragma unroll
        for (int dt = 0; dt < 2; ++dt)
#pragma unroll
            for (int rr = 0; rr < 16; ++rr) ot[dt][rr] = 0.f;
        {
            const LAS unsigned char* vb = lds + DL_VOFF + l31 * DL_VP + 16 * hi + (2 * wave) * 32;
            bf16x8 vfn[2][2];
#pragma unroll
            for (int dt = 0; dt < 2; ++dt)
#pragma unroll
                for (int s2 = 0; s2 < 2; ++s2) vfn[dt][s2] = *(const LAS bf16x8*)(vb + dt * 32 * DL_VP + s2 * 32);
#pragma unroll
            for (int ti = 0; ti < 5; ++ti) {
                bf16x8 vf[2][2];
#pragma unroll
                for (int dt = 0; dt < 2; ++dt)
#pragma unroll
                    for (int s2 = 0; s2 < 2; ++s2) vf[dt][s2] = vfn[dt][s2];
                if (ti < 4) {
#pragma unroll
                    for (int dt = 0; dt < 2; ++dt)
#pragma unroll
                        for (int s2 = 0; s2 < 2; ++s2) vfn[dt][s2] = *(const LAS bf16x8*)(vb + dt * 32 * DL_VP + (2 * (ti + 1) + s2) * 32);
                }
                __builtin_amdgcn_sched_barrier(0);
#pragma unroll
                for (int s2 = 0; s2 < 2; ++s2) { const int r0 = 8 * s2;
                    u32x4 w; w.x = pk2(st[ti][r0], st[ti][r0 + 1]); w.y = pk2(st[ti][r0 + 2], st[ti][r0 + 3]); w.z = pk2(st[ti][r0 + 4], st[ti][r0 + 5]); w.w = pk2(st[ti][r0 + 6], st[ti][r0 + 7]);
                    const bf16x8 pb = __builtin_bit_cast(bf16x8, w);
#pragma unroll
                    for (int dt = 0; dt < 2; ++dt) ot[dt] = __builtin_amdgcn_mfma_f32_32x32x16_bf16(vf[dt][s2], pb, ot[dt], 0, 0, 0); }
                __builtin_amdgcn_sched_barrier(0);
            }
        }
        const float ltot = swapsum(ps);
        const float inv = __builtin_amdgcn_rcpf(ltot);
        float lse2 = mx + __builtin_amdgcn_logf(ltot);
        float wa = 0.f, wg = inv;
        if (gi > 0) { const float mxl = fmaxf(la, lse2);
            const float ea = __builtin_amdgcn_exp2f(la - mxl), eg = __builtin_amdgcn_exp2f(lse2 - mxl); const float den = __builtin_amdgcn_rcpf(ea + eg);
            wa = ea * den; wg = eg * den * inv; lse2 = mxl + __builtin_amdgcn_logf(ea + eg); }
        if (gi < 2 && hi == 0) LSE[row * 16 + head] = lse2;
#pragma unroll
        for (int dt = 0; dt < 2; ++dt)
#pragma unroll
            for (int g4 = 0; g4 < 4; ++g4) { const int d0 = head * 64 + 32 * dt + 8 * g4 + 4 * hi;
                f32x4 o = (f32x4){ot[dt][4 * g4], ot[dt][4 * g4 + 1], ot[dt][4 * g4 + 2], ot[dt][4 * g4 + 3]} * wg;
                if (gi > 0) o += oa[dt][g4] * wa;
                if (gi < 2) *(f32x4*)(Oacc + row * D + d0) = o;
                else { u32x2 w; w.x = pk2(o[0], o[1]); w.y = pk2(o[2], o[3]); *(u32x2*)(Ofin + row * D + d0) = w; } }
    }
    __syncthreads();
#undef DL_LOADV
}

template <int CTRL, int ROWMASK> __device__ __forceinline__ float dppf(float oldv, float v) {
    return __builtin_bit_cast(float, __builtin_amdgcn_update_dpp(__builtin_bit_cast(int, oldv), __builtin_bit_cast(int, v), CTRL, ROWMASK, 0xF, false)); }
template <int CTRL, int ROWMASK> __device__ __forceinline__ void scan_step(float& a, float& b) {
    const float ap = dppf<CTRL, ROWMASK>(1.0f, a), bp = dppf<CTRL, ROWMASK>(0.0f, b);
    b = a * bp + b; a = a * ap;
}
__device__ __forceinline__ float sigmoidf_(float x) { return __builtin_amdgcn_rcpf(1.0f + __builtin_amdgcn_exp2f(-1.4426950408889634f * x)); }
__device__ __forceinline__ void lru_phase(int mode, unsigned char* ldsg, const Args& a, const bf16_t* GU2, const bf16_t* Wfrag, float* AGG, bf16_t* Y, int gw, int NGW, int wave, int lane_in) {
    const int lane = opq(lane_in) & 63;
    LAS float* wl = (LAS float*)((LAS unsigned char*)ldsg + wave * 4096);
    const int tok = lane & 31, hi = lane >> 5;
    int staged_n = -1;
    float* Af = AGG; float* Hf = AGG + (size_t)NB * 64 * 1024; float* Ab = Hf + (size_t)NB * 64 * 1024; float* Hb = Ab + (size_t)NB * 64 * 1024;
    const float* Cf = Hb + (size_t)NB * 64 * 1024; const float* Cb = Cf + (size_t)NB * 64 * 1024;
    for (int item = gw; item < 16 * 16 * 64; item += NGW) {
        const int b = item >> 10, n = (item >> 6) & 15, chunk = item & 63;
        if (n != staged_n) {
            staged_n = n;
            const int ch = 64 * n + lane;
#pragma unroll
            for (int d = 0; d < 2; ++d) {
#pragma unroll
                for (int j = 0; j < 4; ++j) wl[(d * 4 + j) * 64 + lane] = a.in[I_LCW][(d * 4 + j) * 1024 + ch];
                wl[(8 + d) * 64 + lane] = a.in[I_LCB][d * 1024 + ch];
                wl[(10 + d) * 64 + lane] = -1.4426950408889634f * a.in[I_LBA][d * 1024 + ch];
                wl[(12 + d) * 64 + lane] = -1.4426950408889634f * a.in[I_LBX][d * 1024 + ch];
                wl[(14 + d) * 64 + lane] = -11.541560327111707f * log1pf(expf(-a.in[I_LLAM][d * 1024 + ch]));
            }
            asm volatile("s_waitcnt lgkmcnt(0)" ::: "memory");
        }
        const int t = 32 * chunk + tok;
        float hsum[32];
#pragma unroll
        for (int cc = 0; cc < 32; ++cc) hsum[cc] = 0.f;
#pragma unroll 1
        for (int d = 0; d < 2; ++d) {
            float xc[32];
#pragma unroll
            for (int q = 0; q < 8; ++q) { const f32x4 bv = *(const LAS f32x4*)(wl + (8 + d) * 64 + 32 * hi + 4 * q); xc[4 * q] = bv[0]; xc[4 * q + 1] = bv[1]; xc[4 * q + 2] = bv[2]; xc[4 * q + 3] = bv[3]; }
#pragma unroll
            for (int j = 0; j < 4; ++j) {
                const int tt = (d == 0) ? (t - 3 + j) : (t + 3 - j);
                if (tt >= 0 && tt < S) {
                    const bf16_t* up = GU2 + ((size_t)b * S + tt) * 2048 + 1024 + 64 * n + 32 * hi;
#pragma unroll
                    for (int q = 0; q < 4; ++q) { const u32x4 uv = *(const u32x4*)(up + 8 * q);
                        const f32x4 w0 = *(const LAS f32x4*)(wl + (d * 4 + j) * 64 + 32 * hi + 8 * q), w1 = *(const LAS f32x4*)(wl + (d * 4 + j) * 64 + 32 * hi + 8 * q + 4);
                        xc[8 * q + 0] += w0[0] * bflo(uv.x); xc[8 * q + 1] += w0[1] * bfhi(uv.x); xc[8 * q + 2] += w0[2] * bflo(uv.y); xc[8 * q + 3] += w0[3] * bfhi(uv.y);
                        xc[8 * q + 4] += w1[0] * bflo(uv.z); xc[8 * q + 5] += w1[1] * bfhi(uv.z); xc[8 * q + 6] += w1[2] * bflo(uv.w); xc[8 * q + 7] += w1[3] * bfhi(uv.w); }
                }
            }
            bf16x8 bx[4];
#pragma unroll
            for (int ks = 0; ks < 4; ++ks) { u32x4 w; w.x = pk2(xc[8 * ks], xc[8 * ks + 1]); w.y = pk2(xc[8 * ks + 2], xc[8 * ks + 3]); w.z = pk2(xc[8 * ks + 4], xc[8 * ks + 5]); w.w = pk2(xc[8 * ks + 6], xc[8 * ks + 7]); bx[ks] = __builtin_bit_cast(bf16x8, w); }
#pragma unroll
            for (int jt = 0; jt < 2; ++jt) {
                __builtin_amdgcn_sched_barrier(0);
                f32x16 pre[2];
#pragma unroll
                for (int gt = 0; gt < 2; ++gt) {
#pragma unroll
                    for (int rr = 0; rr < 16; ++rr) pre[gt][rr] = 0.f;
#pragma unroll
                    for (int ks = 0; ks < 4; ++ks) { const bf16x8 wf = *(const bf16x8*)(Wfrag + ((size_t)((((d * 16 + n) * 2 + gt) * 2 + jt) * 4 + ks) * 64 + lane) * 8);
                        pre[gt] = __builtin_amdgcn_mfma_f32_32x32x16_bf16(wf, bx[ks], pre[gt], 0, 0, 0); }
                }
                float av[16], bv[16];
#pragma unroll
                for (int rr = 0; rr < 16; ++rr) { const int cc = 16 * jt + rr; const int ch = 32 * hi + cc;
                    const float ra = __builtin_amdgcn_rcpf(1.0f + __builtin_amdgcn_exp2f(pre[0][rr] + wl[(10 + d) * 64 + ch])), ix = __builtin_amdgcn_rcpf(1.0f + __builtin_amdgcn_exp2f(pre[1][rr] + wl[(12 + d) * 64 + ch]));
                    const float la2 = ra * wl[(14 + d) * 64 + ch];
                    const float aa = __builtin_amdgcn_exp2f(la2); av[rr] = aa; bv[rr] = __builtin_amdgcn_sqrtf((1.0f - aa) * (1.0f + aa)) * ix * xc[cc]; }
#define SCAN_DPP(a_, b_, DPPSTR) asm volatile("s_nop 1\n\tv_fmac_f32_dpp %0, %0, %1 " DPPSTR "\n\tv_mul_f32_dpp %1, %1, %1 " DPPSTR : "+v"(b_), "+v"(a_))
#define SCAN_ALL(DPPSTR) do { _Pragma("unroll") for (int rr = 0; rr < 16; ++rr) SCAN_DPP(av[rr], bv[rr], DPPSTR); } while (0)
                asm volatile("s_nop 1" ::: "memory");
                if (d == 0) {
                    SCAN_ALL("row_shr:1 row_mask:0xf bank_mask:0xf"); SCAN_ALL("row_shr:2 row_mask:0xf bank_mask:0xf"); SCAN_ALL("row_shr:4 row_mask:0xf bank_mask:0xf"); SCAN_ALL("row_shr:8 row_mask:0xf bank_mask:0xf");
                    SCAN_ALL("row_bcast:15 row_mask:0xa bank_mask:0xf");
                } else {
                    SCAN_ALL("row_shl:1 row_mask:0xf bank_mask:0xf"); SCAN_ALL("row_shl:2 row_mask:0xf bank_mask:0xf"); SCAN_ALL("row_shl:4 row_mask:0xf bank_mask:0xf"); SCAN_ALL("row_shl:8 row_mask:0xf bank_mask:0xf");
                    const bool lowrow = (lane & 16) == 0;
#pragma unroll
                    for (int rr = 0; rr < 16; ++rr) {
                        const float a16 = __builtin_bit_cast(float, __builtin_amdgcn_readlane(__builtin_bit_cast(int, av[rr]), 16)), a48 = __builtin_bit_cast(float, __builtin_amdgcn_readlane(__builtin_bit_cast(int, av[rr]), 48));
                        const float b16 = __builtin_bit_cast(float, __builtin_amdgcn_readlane(__builtin_bit_cast(int, bv[rr]), 16)), b48 = __builtin_bit_cast(float, __builtin_amdgcn_readlane(__builtin_bit_cast(int, bv[rr]), 48));
                        const float ap = lowrow ? (hi ? a48 : a16) : 1.0f, bp = lowrow ? (hi ? b48 : b16) : 0.0f;
                        bv[rr] = av[rr] * bp + bv[rr]; av[rr] = av[rr] * ap;
                    }
                }
#undef SCAN_ALL
#undef SCAN_DPP
                if (mode == 0) {
                    const bool w = (d == 0) ? (tok == 31) : (tok == 0);
                    if (w) { float* pa = (d == 0 ? Af : Ab) + ((size_t)b * 64 + chunk) * 1024 + 64 * n + 32 * hi + 16 * jt; float* ph = (d == 0 ? Hf : Hb) + ((size_t)b * 64 + chunk) * 1024 + 64 * n + 32 * hi + 16 * jt;
#pragma unroll
                        for (int q = 0; q < 4; ++q) { *(f32x4*)(pa + 4 * q) = (f32x4){av[4 * q], av[4 * q + 1], av[4 * q + 2], av[4 * q + 3]}; *(f32x4*)(ph + 4 * q) = (f32x4){bv[4 * q], bv[4 * q + 1], bv[4 * q + 2], bv[4 * q + 3]}; } }
                } else {
#pragma unroll
                    for (int q = 0; q < 4; ++q) { const f32x4 cv = *(const f32x4*)((d == 0 ? Cf : Cb) + ((size_t)b * 64 + chunk) * 1024 + 64 * n + 32 * hi + 16 * jt + 4 * q);
#pragma unroll
                        for (int e = 0; e < 4; ++e) hsum[16 * jt + 4 * q + e] += bv[4 * q + e] + av[4 * q + e] * cv[e]; }
                }
            }
        }
        if (mode == 1) {
            const size_t row = (size_t)b * S + t;
            const bf16_t* gp = GU2 + row * 2048 + 64 * n + 32 * hi;
            bf16_t* yp = Y + row * D + 64 * n + 32 * hi;
#pragma unroll
            for (int q = 0; q < 4; ++q) { const u32x4 gv = *(const u32x4*)(gp + 8 * q);
                float gx[8] = {bflo(gv.x), bfhi(gv.x), bflo(gv.y), bfhi(gv.y), bflo(gv.z), bfhi(gv.z), bflo(gv.w), bfhi(gv.w)};
                float yv[8];
#pragma unroll
                for (int e = 0; e < 8; ++e) { const float x = gx[e]; const float z = 0.7978845608028654f * (x + 0.044715f * x * x * x); yv[e] = (x * __builtin_amdgcn_rcpf(1.0f + __builtin_amdgcn_exp2f(-2.8853900817779268f * z))) * hsum[8 * q + e]; }
                u32x4 w; w.x = pk2(yv[0], yv[1]); w.y = pk2(yv[2], yv[3]); w.z = pk2(yv[4], yv[5]); w.w = pk2(yv[6], yv[7]);
                *(u32x4*)(yp + 8 * q) = w; }
        }
    }
}


__device__ __forceinline__ void lru_carry(float* AGG, int tid_in) {
    const int e = (int)blockIdx.x * NT + opq(tid_in);
    if (e < 2 * NB * 1024) {
    const int ch = e & 1023, b = (e >> 10) & 15, d = e >> 14;
    const size_t plane = (size_t)NB * 64 * 1024;
    const float* A = AGG + (d == 0 ? 0 : 2 * plane); const float* Hh = A + plane; float* C = AGG + (4 + d) * plane;
    float c = 0.f;
#pragma unroll 1
    for (int k0 = 0; k0 < 64; k0 += 16) {
        float av[16], hv[16];
#pragma unroll
        for (int j = 0; j < 16; ++j) { const int k = (d == 0) ? (k0 + j) : (63 - k0 - j); const size_t o = ((size_t)b * 64 + k) * 1024 + ch; av[j] = A[o]; hv[j] = Hh[o]; }
#pragma unroll
        for (int j = 0; j < 16; ++j) { const int k = (d == 0) ? (k0 + j) : (63 - k0 - j); C[((size_t)b * 64 + k) * 1024 + ch] = c; c = av[j] * c + hv[j]; }
    }
    }
}


template <int G> __device__ __forceinline__ void pool_group8(const float* x, const float* rstd0, const float* gain, bf16_t* MO, size_t rb, int t0, int lane) {
    constexpr int HALF = 1 << G, WIN = 2 * HALF, NR = WIN + 7;
    f32x4 rowv[NR];
#pragma unroll
    for (int i = 0; i < NR; ++i) { const int tt = t0 - HALF + i;
        rowv[i] = (tt >= 0 && tt < S) ? *((const f32x4*)(x + (rb + tt) * D + 256 * G) + lane) * rstd0[rb + tt] : (f32x4){0.f, 0.f, 0.f, 0.f}; }
    const f32x4 gv = *((const f32x4*)(gain + 256 * G) + lane);
    f32x4 sum = (f32x4){0.f, 0.f, 0.f, 0.f};
#pragma unroll
    for (int i = 0; i < WIN; ++i) sum += rowv[i];
#pragma unroll
    for (int j = 0; j < 8; ++j) { const int t = t0 + j; const int lo = max(t - HALF, 0), hi = min(t + HALF, S);
        const f32x4 p = (sum * (1.0f / (float)(hi - lo)) - rowv[j + HALF]) * gv;
        u32x2 w; w.x = pk2(p[0], p[1]); w.y = pk2(p[2], p[3]);
        *((u32x2*)(MO + (rb + t) * D + 256 * G) + lane) = w;
        if (j < 7) sum += rowv[j + WIN] - rowv[j]; }
}

#ifndef GMASK
#define GMASK 0xffff
#endif
#define GSITE(n, stmt) do { if constexpr ((GMASK >> (n)) & 1) { stmt; } } while (0)

#define XB_TMO      128
#define XB_XCNT(j)  (256  + 64 * (j))
#define XB_XSUB(j)  (1280 + 64 * (j))
#define XB_XGEN(j)  (2304 + 64 * (j))
#define XB_TOP      3328
#define XB_TOPGEN   3392
#define XCD_BAR_WORDS 3456
#define XB_SPIN_CAP (1u << 18)
__device__ __forceinline__ unsigned xb_ld(unsigned* p)              { return __hip_atomic_load(p, __ATOMIC_RELAXED, __HIP_MEMORY_SCOPE_AGENT); }
__device__ __forceinline__ unsigned xb_add(unsigned* p, unsigned v) { return __hip_atomic_fetch_add(p, v, __ATOMIC_RELAXED, __HIP_MEMORY_SCOPE_AGENT); }
__device__ __forceinline__ unsigned xb_xcc_id() { return (unsigned)__builtin_amdgcn_s_getreg((3 << 11) | 20) & 0xFu; }
#define XB_SPIN(cond, bar) do { unsigned _sp = 0; while (cond) { __builtin_amdgcn_s_sleep(1); \
    if ((++_sp & 255u) == 0u) { if (xb_ld(&(bar)[XB_TMO])) break; if (_sp > XB_SPIN_CAP) { atomicAdd(&(bar)[XB_TMO], 1u); break; } } } } while (0)
struct XcdBarrier { unsigned* bar; unsigned x; volatile LAS unsigned* st; };
__device__ __forceinline__ XcdBarrier xcd_barrier_post(unsigned* bar, volatile LAS unsigned* st, bool leader) {
    XcdBarrier b; b.bar = bar; b.x = xb_xcc_id(); b.st = st;
    if (leader) (void)xb_add(&bar[XB_XCNT(b.x)], 1u);
    return b;
}
__device__ __forceinline__ void xcd_barrier_complete(unsigned* bar, unsigned x, unsigned& nloc, unsigned& nx) {
    const unsigned G = gridDim.x * gridDim.y * gridDim.z;
    unsigned sum, cnt, mine, sp = 0u;
    for (;;) {
        sum = 0u; cnt = 0u; mine = 0u;
#pragma unroll 1
        for (unsigned j = 0; j < 16; ++j) { const unsigned c = xb_ld(&bar[XB_XCNT(j)]); sum += c; cnt += (c > 0u) ? 1u : 0u; mine = (j == x) ? c : mine; }
        if (sum == G) break;
        __builtin_amdgcn_s_sleep(1);
        if ((++sp & 255u) == 0u) { if (xb_ld(&bar[XB_TMO])) break; if (sp > XB_SPIN_CAP) { atomicAdd(&bar[XB_TMO], 1u); break; } }
    }
    nloc = mine > 0u ? mine : 1u; nx = cnt > 0u ? cnt : 1u;
}
__device__ __forceinline__ void xcd_barrier(const XcdBarrier& b, bool leader) {
    asm volatile("s_waitcnt vmcnt(0)" ::: "memory");
    __syncthreads();
    if (leader) {
        unsigned* bar = b.bar;
        __builtin_amdgcn_s_waitcnt(0);
        unsigned nloc = b.st[0], nx = b.st[1];
        if (nloc == 0u) { xcd_barrier_complete(bar, b.x, nloc, nx); b.st[0] = nloc; b.st[1] = nx; }
        const unsigned old = xb_add(&bar[XB_XSUB(b.x)], 1u);
        const unsigned gen = old / nloc;
        if (old + 1u == (gen + 1u) * nloc) {
            __builtin_amdgcn_fence(__ATOMIC_RELEASE, "agent");
            asm volatile("s_waitcnt vmcnt(0)" ::: "memory");
            const unsigned og = xb_add(&bar[XB_TOP], 1u);
            const unsigned tg = og / nx;
            if (og + 1u == (tg + 1u) * nx) xb_add(&bar[XB_TOPGEN], 1u);
            else XB_SPIN(xb_ld(&bar[XB_TOPGEN]) == tg, bar);
            __builtin_amdgcn_fence(__ATOMIC_ACQUIRE, "agent");
            xb_add(&bar[XB_XGEN(b.x)], 1u);
            asm volatile("s_waitcnt vmcnt(0)" ::: "memory");
        } else {
            XB_SPIN(xb_ld(&bar[XB_XGEN(b.x)]) == gen, bar);
            __builtin_amdgcn_fence(__ATOMIC_ACQUIRE, "agent");
            asm volatile("s_waitcnt vmcnt(0)" ::: "memory");
        }
    }
    __syncthreads();
}

#ifdef PROBE
#define TICK(k) do { const unsigned long long now_ = __builtin_amdgcn_s_memrealtime(); cls[k] += (unsigned)(now_ - tlast); tlast = now_; } while (0)
#else
#define TICK(k) do {} while (0)
#endif
#define PSYNC(k) do { TICK(k); { XcdBarrier xb_; xb_.bar = (unsigned*)(a.ws + T_CTL); xb_.x = xb_xcc_id(); xb_.st = (volatile LAS unsigned*)(ldsl + 131072 + 1024); xcd_barrier(xb_, wave == 0 && lane_id() == 0); } TICK(0); } while (0)
__global__ void __launch_bounds__(NT, 2) fwd(Args a) {
    extern __shared__ __attribute__((aligned(16))) unsigned char lds[];
    cg::grid_group grid = cg::this_grid();
    const int wave = __builtin_amdgcn_readfirstlane((int)threadIdx.x >> 6);
#define tid ((wave << 6) | lane_id())
    const int gw = blockIdx.x * 8 + wave, NGW = gridDim.x * 8;
    LAS unsigned char* ldsl = (LAS unsigned char*)lds;
    LAS float* scr = (LAS float*)(ldsl + wave * 16384);
    unsigned char* ws = a.ws;
    bf16_t* XN = (bf16_t*)(ws + WS_XN); bf16_t* MO = (bf16_t*)(ws + WS_MO); float* RSS = (float*)(ws + T_RSS);
    float* cosT = (float*)(ws + T_COS); float* sinT = (float*)(ws + T_SIN); float* rstd0 = (float*)(ws + T_RSTD);
    float* H = a.out;
    volatile LAS unsigned* misc = (volatile LAS unsigned*)(ldsl + 131072 + 1024);
    if (tid < 2) misc[tid] = 0u;
    __syncthreads();
    (void)xcd_barrier_post((unsigned*)(ws + T_CTL), misc, wave == 0 && lane_id() == 0);
#ifdef PROBE
    unsigned cls[8] = {0, 0, 0, 0, 0, 0, 0, 0}; unsigned long long tlast = __builtin_amdgcn_s_memrealtime();
#endif

    {
        for (int g = 0; g < 4; ++g) transpose_mat(a.in[I_POOLW] + (size_t)g * 65536, 256, 256, 256, 0, (bf16_t*)(ws + W_POOL) + (size_t)g * 65536, 0, scr, gw, NGW, tid);
        transpose_mat(a.in[I_DQKV], D, 2048, 3072, 0, (bf16_t*)(ws + W_DQK), 1, scr, gw, NGW, tid, a.in[I_MIXNORM] + 1 * D);
        transpose_mat(a.in[I_DQKV], D, 1024, 3072, 2048, (bf16_t*)(ws + W_DV), 0, scr, gw, NGW, tid, a.in[I_MIXNORM] + 1 * D);
        transpose_mat(a.in[I_DWO], D, D, D, 0, (bf16_t*)(ws + W_DO), 0, scr, gw, NGW, tid);
        transpose_mat(a.in[I_LWIN], D, 2048, 2048, 0, (bf16_t*)(ws + W_LIN), 0, scr, gw, NGW, tid, a.in[I_MIXNORM] + 2 * D);
        transpose_mat(a.in[I_LWOUT], D, D, D, 0, (bf16_t*)(ws + W_LOUT), 0, scr, gw, NGW, tid);
        transpose_mat(a.in[I_XQKV], D, 9216, 9216, 0, (bf16_t*)(ws + W_XQKV), 2, scr, gw, NGW, tid, a.in[I_MIXNORM] + 3 * D);
        transpose_mat(a.in[I_XWO], D, D, D, 0, (bf16_t*)(ws + W_XO), 0, scr, gw, NGW, tid);
        convert_ffn(a, 0, scr, gw, NGW, tid);
        for (int e = blockIdx.x * NT + tid; e < 2 * 16 * 2 * 2 * 4 * 64; e += gridDim.x * NT) {
            const int ln = e & 63, ks = (e >> 6) & 3, jt = (e >> 8) & 1, gt = (e >> 9) & 1, n = (e >> 10) & 15, d = e >> 14;
            const int rho = (ln & 31) + 32 * jt, hi = ln >> 5;
            const int jout = 32 * ((rho >> 2) & 1) + 4 * (rho >> 3) + (rho & 3);
            const float* Wg = (gt == 0 ? a.in[I_LWA] : a.in[I_LWX]) + (size_t)(d * 16 + n) * 4096;
            u32x4 w; float v[8];
#pragma unroll
            for (int j8 = 0; j8 < 8; ++j8) v[j8] = -1.4426950408889634f * Wg[(32 * hi + 8 * ks + j8) * 64 + jout];
            w.x = pk2(v[0], v[1]); w.y = pk2(v[2], v[3]); w.z = pk2(v[4], v[5]); w.w = pk2(v[6], v[7]);
            *(u32x4*)((bf16_t*)(ws + W_LG) + (size_t)e * 8) = w;
        }
        for (int e = blockIdx.x * NT + tid; e < S * 32; e += gridDim.x * NT) {
            const int t = e >> 5, i = e & 31;
            const float inv = exp2f(-(float)i * (13.287712379549449f / 32.0f));
            const float ang = (float)((const int*)a.in[I_POS])[t] * inv;
            cosT[e] = cosf(ang); sinT[e] = sinf(ang);
        }
        const int lane = opq(tid) & 63;
        for (int m = gw; m < M; m += NGW) {
            const f32x4* xr = (const f32x4*)(a.in[I_X] + (size_t)m * D) + lane; float s = 0.f;
#pragma unroll
            for (int j = 0; j < 4; ++j) { const f32x4 v = xr[64 * j]; s += (v.x * v.x + v.y * v.y) + (v.z * v.z + v.w * v.w); }
            s = wave_sum(s);
            if (lane == 0) rstd0[m] = 1.0f / sqrtf(s * (1.f / D) + 1e-6f);
        }
    }
    TICK(7); grid.sync(); TICK(0);

    for (int layer = 0; layer < 4; ++layer) {
        if (layer == 0) {
            const float* x = a.in[I_X]; const float* gain = a.in[I_MIXNORM]; const int lane = (opq(tid) & 63);
            for (int m8 = gw; m8 < M / 8; m8 += NGW) {
                const int m0 = 8 * m8, t0 = m0 & (S - 1); const size_t rb = (size_t)(m0 - t0);
                pool_group8<0>(x, rstd0, gain, MO, rb, t0, lane); pool_group8<1>(x, rstd0, gain, MO, rb, t0, lane);
                pool_group8<2>(x, rstd0, gain, MO, rb, t0, lane); pool_group8<3>(x, rstd0, gain, MO, rb, t0, lane);
            }
            PSYNC(7);
        } else {
            convert_ffn(a, layer, scr, gw, NGW, tid);
            __syncthreads();
            if (layer == 1) {
                bf16_t* QK = (bf16_t*)(ws + WS_SCR); bf16_t* Vt = (bf16_t*)(ws + WS_SCR + 128 * MiB);
                { pg8::Gemm g{XN, (const bf16_t*)(ws + W_DQK), D, D, D, 0, 0, 128, 8}; pg8::EpiRope E{ws, 0, QSCALE}; GSITE(1, pg8::gemm_phase(ldsl, g, E, wave)); }
                { pg8::Gemm g{(const bf16_t*)(ws + W_DV), XN, D, D, D, 0, 0, 4, 128}; pg8::EpiPlain E{ws, WS_SCR + 128 * MiB, (size_t)M, 2, 0}; GSITE(2, pg8::gemm_phase(ldsl, g, E, wave)); }
                PSYNC(1);
                float s1 = 0.f, s2 = 0.f;
                for (int i = 0; i < 64; ++i) { s1 += a.in[I_LQ1][i] * a.in[I_LK1][i]; s2 += a.in[I_LQ2][i] * a.in[I_LK2][i]; }
                const float lam_init = 0.8f - 0.6f * expf(-0.3f * 1.0f);
                const float lam = expf(s1) - expf(s2) + lam_init;
#ifndef NO_DIFF
                diff_attn_phase(lds, QK, Vt, MO, lam, lam_init, a.in[I_SUBLN], wave);
#endif
                PSYNC(4);
            } else if (layer == 2) {
                bf16_t* GU2 = (bf16_t*)(ws + WS_SCR);
                { pg8::Gemm g{XN, (const bf16_t*)(ws + W_LIN), D, D, D, 0, 0, 128, 8}; pg8::EpiPlain E{ws, WS_SCR, 2048, 1, 0}; GSITE(3, pg8::gemm_phase(ldsl, g, E, wave)); }
                PSYNC(1);
#ifndef NO_LRU
                lru_phase(0, lds, a, GU2, (const bf16_t*)(ws + W_LG), (float*)(ws + T_AGG), MO, gw, NGW, wave, tid);
#endif
                PSYNC(5);
                lru_carry((float*)(ws + T_AGG), tid);
                PSYNC(5);
#ifndef NO_LRU
                lru_phase(1, lds, a, GU2, (const bf16_t*)(ws + W_LG), (float*)(ws + T_AGG), MO, gw, NGW, wave, tid);
#endif
                PSYNC(5);
            } else {
                bf16_t* QKg = (bf16_t*)(ws + WS_SCR); bf16_t* Vtg = (bf16_t*)(ws + WS_SCR + 128 * MiB); float* Oacc = (float*)(ws + WS_SCR + 192 * MiB); float* LSE = (float*)(ws + T_LSE);
                for (int gi = 0; gi < 3; ++gi) {
                    const bf16_t* Wg = (const bf16_t*)(ws + W_XQKV) + (size_t)gi * 3072 * D;
                    { pg8::Gemm g{XN, Wg, D, D, D, gi, 0, 128, 8}; pg8::EpiRope E{ws, gi, QSCALE}; GSITE(4, pg8::gemm_phase(ldsl, g, E, wave)); }
                    { pg8::Gemm g{Wg + (size_t)2048 * D, XN, D, D, D, 0, gi, 4, 128}; pg8::EpiPlain E{ws, WS_SCR + 128 * MiB, (size_t)M, 2, gi}; GSITE(5, pg8::gemm_phase(ldsl, g, E, wave)); }
                    PSYNC(1);
#ifndef NO_DIL
                    dil_attn_phase(gi, lds, QKg, Vtg, Oacc, LSE, MO, wave);
#endif
                    PSYNC(6);
                }
            }
        }
        {
            pg8::Gemm g{MO, (const bf16_t*)(ws + (layer == 0 ? W_POOL : layer == 1 ? W_DO : layer == 2 ? W_LOUT : W_XO)), layer == 0 ? 256 : D, D, layer == 0 ? 256 : D, layer == 0 ? 3 : 0, 0, 128, 4};
            pg8::EpiResid E{layer == 0 ? a.in[I_X] : nullptr, layer == 0 ? a.in[I_POOLS] : nullptr, ws, (LAS float*)(ldsl + 133120)};
            GSITE(6, pg8::gemm_phase(ldsl, g, E, wave));
        }
        PSYNC(1);
        bf16_t* ACT = (bf16_t*)(ws + WS_SCR); float* SB = (float*)(ws + WS_SCR + 176 * MiB);
        const float* cw = a.in[I_FCW] + (size_t)layer * 3 * DFF; const float* cb = a.in[I_FCB] + (size_t)layer * DFF;
        { pg8::Gemm g{XN, (const bf16_t*)(ws + W_UP), D, D, D, 0, 0, 128, 22}; pg8::EpiFfnUp E{ws, cw, cb}; GSITE(7, pg8::gemm_phase(ldsl, g, E, wave)); }
        PSYNC(1);
        {
            const int tidl = opq(tid);
            pg8::StaticOrder So; So.init(128, 4, (int)gridDim.x, (int)blockIdx.x); pg8::Unit uu;
            int lastpm = -1;
            for (int i = 0; So.next(i, uu); ++i) {
                if (uu.pm == lastpm) continue;
                lastpm = uu.pm;
                for (int idx = tidl; idx < 8 * (DFF / 8); idx += NT) {
                    const int rk = idx / (DFF / 8), c0 = 8 * (idx % (DFF / 8)); const int k = rk >> 1, last = rk & 1;
                    const int G = 4 * uu.pm + k; const int row = 64 * G + (last ? 63 : 0); const int t = row & (S - 1);
                    const float* pp = SB + ((size_t)last * 512 + G) * DFF + c0;
                    const bool hasn = last ? (t < S - 1) : (t > 0);
                    const float* nb = SB + ((size_t)(last ? 2 : 3) * 512 + (last ? G + 1 : G - 1)) * DFF + c0;
                    const float* wt = cw + (last ? 2 * DFF : 0) + c0;
                    float o[8];
#pragma unroll
                    for (int h2 = 0; h2 < 2; ++h2) {
                        f32x4 p = *(const f32x4*)(pp + 4 * h2); const f32x4 uv = *(const f32x4*)(pp + (size_t)4 * 512 * DFF + 4 * h2);
                        if (hasn) p += *(const f32x4*)(wt + 4 * h2) * *(const f32x4*)(nb + 4 * h2);
                        const f32x2 a0 = gelu_pk((f32x2){p[0], p[1]}), a1 = gelu_pk((f32x2){p[2], p[3]});
                        o[4 * h2] = a0.x * uv[0]; o[4 * h2 + 1] = a0.y * uv[1]; o[4 * h2 + 2] = a1.x * uv[2]; o[4 * h2 + 3] = a1.y * uv[3];
                    }
                    u32x4 w; w.x = pk2(o[0], o[1]); w.y = pk2(o[2], o[3]); w.z = pk2(o[4], o[5]); w.w = pk2(o[6], o[7]);
                    *(u32x4*)(ACT + (size_t)row * DFF + c0) = w;
                }
            }
            asm volatile("s_waitcnt vmcnt(0)" ::: "memory");
            __syncthreads();
        }
        { pg8::Gemm g{ACT, (const bf16_t*)(ws + W_DOWN), DFF, DFF, DFF, 0, 0, 128, 4}; pg8::EpiResid E{nullptr, nullptr, ws, (LAS float*)(ldsl + 133120)}; GSITE(8, pg8::gemm_phase(ldsl, g, E, wave)); }
        PSYNC(1);
    }
    {
        const int lane = (opq(tid) & 63);
        f32x4 gv[4];
#pragma unroll
        for (int j = 0; j < 2; ++j) { gv[2 * j] = *(const f32x4*)(a.in[I_FINAL] + 8 * lane + 512 * j); gv[2 * j + 1] = *(const f32x4*)(a.in[I_FINAL] + 8 * lane + 512 * j + 4); }
        for (int m = gw; m < M; m += NGW) {
            const float r = pg8::rstd_of(RSS, (size_t)m);
#pragma unroll
            for (int j = 0; j < 2; ++j) { const u32x4 v = *(const u32x4*)(XN + (size_t)m * D + 8 * lane + 512 * j);
                *(f32x4*)(H + (size_t)m * D + 8 * lane + 512 * j) = (f32x4){bflo(v.x), bfhi(v.x), bflo(v.y), bfhi(v.y)} * r * gv[2 * j];
                *(f32x4*)(H + (size_t)m * D + 8 * lane + 512 * j + 4) = (f32x4){bflo(v.z), bfhi(v.z), bflo(v.w), bfhi(v.w)} * r * gv[2 * j + 1]; }
        }
    }
#ifdef PROBE
    TICK(2);
    grid.sync();
    if (blockIdx.x == 0) {
        const unsigned v = cls[PROBE_RVR] / 1000u;
        for (unsigned i = tid; i < 16u * v; i += NT) H[i] += 0.05f;
        const unsigned long long t0 = __builtin_amdgcn_s_memrealtime(); const unsigned long long want = 2ull * cls[PROBE_DUR];
        while (__builtin_amdgcn_s_memrealtime() - t0 < want) __builtin_amdgcn_s_sleep(16);
    }
#endif
}

#undef tid
extern "C" void kernel_launch(void* const* d_in, const int* in_sizes, int n_in, void* d_out, int out_size, void* d_ws, size_t ws_size, hipStream_t stream) {
    static int grid = 0;
    if (grid == 0) {
        if (n_in != 29 || in_sizes[0] != M * D || out_size != M * D || ws_size < WS_END) { fprintf(stderr, "kernel_launch: unexpected shapes (n_in %d, ws %zu)\n", n_in, ws_size); grid = -1; return; }
        int dev = 0, cus = 0, per_cu = 0;
        (void)hipGetDevice(&dev);
        (void)hipDeviceGetAttribute(&cus, hipDeviceAttributeMultiprocessorCount, dev);
        (void)hipFuncSetAttribute((const void*)fwd, hipFuncAttributeMaxDynamicSharedMemorySize, LDS_BYTES);
        (void)hipOccupancyMaxActiveBlocksPerMultiprocessor(&per_cu, (const void*)fwd, NT, LDS_BYTES);
        if (per_cu < 1) per_cu = 1;
        grid = cus;
        (void)hipGetLastError();
    }
    if (grid < 0) return;
    if (hipMemsetAsync((char*)d_ws + T_CTL, 0, 16384, stream) != hipSuccess) { fprintf(stderr, "kernel_launch: memset failed\n"); return; }
    Args a{};
    for (int i = 0; i < 29; ++i) a.in[i] = (const float*)d_in[i];
    a.out = (float*)d_out; a.ws = (unsigned char*)d_ws;
    void* args[] = {&a};
    hipError_t e = hipLaunchCooperativeKernel((void*)fwd, dim3(grid), dim3(NT), args, LDS_BYTES, stream);
    if (e != hipSuccess) fprintf(stderr, "cooperative launch failed: %s\n", hipGetErrorString(e));
}
```
